# Optimizing an MI355X kernel written in HIP

```python
import math
import jax, jax.numpy as jnp
from jax import lax
import numpy as np

D_MODEL = 1024
BATCH = 4
SEQ = 8192
DEPTH = 1

RWKV_HEAD = 64
RWKV_HEADS = D_MODEL // RWKV_HEAD
RWKV_WIDTH = RWKV_HEADS * RWKV_HEAD
LORA_DECAY = 64
LORA_ICLR = 64
LORA_GATE = 160
GN_EPS = 64e-5
ATTN_HEAD = 64
ATTN_HEADS_PER_GROUP = 8
ATTN_GROUPS = ((128, 1), (512, 4), (2048, 16))
N_ATTN_GROUPS = 3
ATTN_WIDTH = N_ATTN_GROUPS * ATTN_HEADS_PER_GROUP * ATTN_HEAD
ATTN_OUT = ATTN_HEADS_PER_GROUP * ATTN_HEAD
BLK = 128
FFN_HIDDEN = -(-8 * D_MODEL // (3 * 256)) * 256
RMS_EPS = 1e-6
PROJ_SIZES = (RWKV_WIDTH, RWKV_WIDTH, RWKV_WIDTH, ATTN_WIDTH, ATTN_WIDTH, ATTN_WIDTH, D_MODEL, D_MODEL)
PROJ_IN = 3 * RWKV_WIDTH + 3 * ATTN_WIDTH + 2 * D_MODEL

kernel_name = 'hybrid_rwkv7_dilated_alibi_block'


def _rmsnorm(t, g):
    t32 = t.astype(jnp.float32)
    n = t32 * lax.rsqrt(jnp.mean(t32 * t32, axis=-1, keepdims=True) + RMS_EPS)
    return n.astype(t.dtype) * g


def _shift(t):
    return jnp.pad(t, ((0, 0), (1, 0), (0, 0)))[:, :-1]


def _split_cols(t, sizes):
    idx, acc = [], 0
    for s in sizes[:-1]:
        acc += s
        idx.append(acc)
    return jnp.split(t, idx, axis=-1)


def _alibi_slopes(n):
    def pow2(m):
        start = 2.0 ** (-8.0 / m)
        return [start ** (i + 1) for i in range(m)]
    if math.log2(n).is_integer():
        s = pow2(n)
    else:
        p = 2 ** int(math.floor(math.log2(n)))
        s = pow2(p) + pow2(2 * p)[0::2][: n - p]
    return sorted(s, reverse=True)


def _rwkv7_recurrence(r, decay, k, v, a_vec, b_vec):
    B, T, H, N = r.shape

    def step(S, inp):
        r_t, w_t, k_t, v_t, a_t, b_t = inp
        Sa = jnp.einsum('bhij,bhj->bhi', S, a_t)
        S = S * w_t[:, :, None, :] + Sa[..., None] * b_t[:, :, None, :] + v_t[..., None] * k_t[:, :, None, :]
        return S, jnp.einsum('bhij,bhj->bhi', S, r_t)

    xs = tuple(jnp.moveaxis(t, 1, 0) for t in (r, decay, k, v, a_vec, b_vec))
    _, y = lax.scan(step, jnp.zeros((B, H, N, N), jnp.float32), xs)
    return jnp.moveaxis(y, 0, 1)


def _rwkv7_branch(h, p_r, p_k, p_v, mu_rkv, mu_lora, w0, w1, w2, a0, a1, a2, g1, g2, k_k, k_a, r_k, ln_x_w, ln_x_b, w_o):
    B, T, _ = h.shape
    f32 = jnp.float32
    r = p_r + (_shift(p_r) - p_r) * mu_rkv[0]
    k = p_k + (_shift(p_k) - p_k) * mu_rkv[1]
    v = p_v + (_shift(p_v) - p_v) * mu_rkv[2]
    dh = _shift(h) - h
    xw = h + dh * mu_lora[0]
    xa = h + dh * mu_lora[1]
    xg = h + dh * mu_lora[2]
    w_log = -jax.nn.softplus(-(w0 + jnp.tanh(xw @ w1) @ w2)) - 0.5
    decay = jnp.exp(-jnp.exp(w_log.astype(f32)))
    a = jax.nn.sigmoid(a0 + (xa @ a1) @ a2)
    g = jax.nn.sigmoid(xg @ g1) @ g2
    heads = lambda t: t.reshape(B, T, RWKV_HEADS, RWKV_HEAD)
    kk = heads(k * k_k).astype(f32)
    kk = kk / jnp.maximum(jnp.sqrt(jnp.sum(kk * kk, axis=-1, keepdims=True)), 1e-12)
    k = k * (1 + (a - 1) * k_a)
    r_h, k_h, v_h, a_h = heads(r), heads(k), heads(v), heads(a)
    y = _rwkv7_recurrence(r_h.astype(f32), heads(decay), k_h.astype(f32), v_h.astype(f32),
                          -kk, kk * a_h.astype(f32))
    mean = jnp.mean(y, axis=-1, keepdims=True)
    var = jnp.mean(jnp.square(y - mean), axis=-1, keepdims=True)
    y = ((y - mean) * lax.rsqrt(var + GN_EPS)).astype(h.dtype).reshape(B, T, RWKV_WIDTH) * ln_x_w + ln_x_b
    bonus = jnp.sum(r_h * k_h * r_k, axis=-1, keepdims=True) * v_h
    y = (y + bonus.reshape(B, T, RWKV_WIDTH)) * g
    return y @ w_o


def _dilated_window_attention(q, k, v, slopes, window, dilation):
    B, T, H, D = q.shape
    span = window // dilation
    L = T // dilation
    Lp = -(-L // BLK) * BLK
    nb = Lp // BLK

    def blocks(t):
        t = t.reshape(B, L, dilation, H, D)
        t = jnp.pad(t, ((0, 0), (0, Lp - L), (0, 0), (0, 0), (0, 0)))
        return t.reshape(B, nb, BLK, dilation, H, D)

    def band(t):
        prev = jnp.pad(t, ((0, 0), (1, 0), (0, 0), (0, 0), (0, 0), (0, 0)))[:, :-1]
        return jnp.concatenate([prev, t], axis=2)

    qb = blocks(q)
    kc, vc = band(blocks(k)), band(blocks(v))
    s = jnp.einsum('bnqrhd,bnkrhd->bnrhqk', qb, kc, preferred_element_type=jnp.float32) * (D ** -0.5)
    iq = jnp.arange(BLK)[:, None]
    jk = jnp.arange(2 * BLK)[None, :]
    delta = iq - jk + BLK
    nidx = jnp.arange(nb)[:, None, None]
    valid = ((delta >= 0) & (delta <= span))[None] & ((nidx > 0) | (jk[None] >= BLK))
    dist = (delta * dilation).astype(jnp.float32)
    s = s - slopes[:, None, None] * dist[None]
    s = jnp.where(valid[None, :, None, None], s, -jnp.inf)
    m = jnp.max(s, axis=-1, keepdims=True)
    p = jnp.exp(s - m)
    den = jnp.sum(p, axis=-1, keepdims=True)
    o = jnp.einsum('bnrhqk,bnkrhd->bnqrhd', p / den, vc.astype(jnp.float32))
    lse = jnp.transpose((m + jnp.log(den))[..., 0], (0, 1, 4, 2, 3))
    o = o.reshape(B, Lp, dilation, H, D)[:, :L].reshape(B, T, H, D)
    lse = lse.reshape(B, Lp, dilation, H)[:, :L].reshape(B, T, H)
    return o, lse


def setup_inputs(seed: int = 0) -> dict:
    key = jax.random.key(seed)
    ks = jax.random.split(key, 32)
    f32 = jnp.float32
    nrm = lambda k, shape, scale: jax.random.normal(k, shape, f32) * scale
    return {
        'x': nrm(ks[0], (BATCH, SEQ, D_MODEL), 1.0),
        'c': nrm(ks[1], (BATCH, D_MODEL), 1.0),
        'w_mod': nrm(ks[2], (DEPTH, D_MODEL, 6 * D_MODEL), 0.5 * D_MODEL ** -0.5),
        'b_mod': nrm(ks[3], (DEPTH, 6 * D_MODEL), 0.01),
        'g_pre_mix': 1.0 + nrm(ks[4], (DEPTH, D_MODEL), 0.05),
        'g_post_mix': 1.0 + nrm(ks[5], (DEPTH, D_MODEL), 0.05),
        'g_pre_ffn': 1.0 + nrm(ks[6], (DEPTH, D_MODEL), 0.05),
        'g_post_ffn': 1.0 + nrm(ks[7], (DEPTH, D_MODEL), 0.05),
        'w_in': nrm(ks[8], (DEPTH, D_MODEL, PROJ_IN), D_MODEL ** -0.5),
        'mu_rkv': jax.random.uniform(ks[9], (DEPTH, 3, RWKV_WIDTH), f32),
        'mu_lora': jax.random.uniform(ks[10], (DEPTH, 3, D_MODEL), f32),
        'w0': jax.random.uniform(ks[11], (DEPTH, RWKV_WIDTH), f32, -4.0, 1.0),
        'w1': nrm(ks[12], (DEPTH, D_MODEL, LORA_DECAY), D_MODEL ** -0.5),
        'w2': nrm(ks[13], (DEPTH, LORA_DECAY, RWKV_WIDTH), 0.5 * LORA_DECAY ** -0.5),
        'a0': nrm(ks[14], (DEPTH, RWKV_WIDTH), 0.1),
        'a1': nrm(ks[15], (DEPTH, D_MODEL, LORA_ICLR), D_MODEL ** -0.5),
        'a2': nrm(ks[16], (DEPTH, LORA_ICLR, RWKV_WIDTH), LORA_ICLR ** -0.5),
        'g1': nrm(ks[17], (DEPTH, D_MODEL, LORA_GATE), D_MODEL ** -0.5),
        'g2': nrm(ks[18], (DEPTH, LORA_GATE, RWKV_WIDTH), LORA_GATE ** -0.5),
        'k_k': 0.85 + nrm(ks[19], (DEPTH, RWKV_WIDTH), 0.05),
        'k_a': 1.0 + nrm(ks[20], (DEPTH, RWKV_WIDTH), 0.05),
        'r_k': nrm(ks[21], (DEPTH, RWKV_HEADS, RWKV_HEAD), 0.1),
        'ln_x_w': 1.0 + nrm(ks[22], (DEPTH, RWKV_WIDTH), 0.05),
        'ln_x_b': nrm(ks[23], (DEPTH, RWKV_WIDTH), 0.01),
        'w_o_rwkv': nrm(ks[24], (DEPTH, RWKV_WIDTH, D_MODEL), RWKV_WIDTH ** -0.5),
        'w_o_attn': nrm(ks[25], (DEPTH, ATTN_OUT, D_MODEL), ATTN_OUT ** -0.5),
        'w_out': nrm(ks[26], (DEPTH, D_MODEL, D_MODEL), D_MODEL ** -0.5),
        'w_ffn_in': nrm(ks[27], (DEPTH, D_MODEL, 2 * FFN_HIDDEN), D_MODEL ** -0.5),
        'w_ffn_out': nrm(ks[28], (DEPTH, FFN_HIDDEN, D_MODEL), FFN_HIDDEN ** -0.5),
    }


def reference(x, c, w_mod, b_mod, g_pre_mix, g_post_mix, g_pre_ffn, g_post_ffn, w_in, mu_rkv, mu_lora,
              w0, w1, w2, a0, a1, a2, g1, g2, k_k, k_a, r_k, ln_x_w, ln_x_b, w_o_rwkv, w_o_attn, w_out,
              w_ffn_in, w_ffn_out):
    B, T, _ = x.shape
    slopes = jnp.asarray(_alibi_slopes(N_ATTN_GROUPS * ATTN_HEADS_PER_GROUP), jnp.float32)
    slopes = slopes.reshape(N_ATTN_GROUPS, ATTN_HEADS_PER_GROUP)
    for l in range(DEPTH):
        mod = (c @ w_mod[l] + b_mod[l])[:, None, :]
        sh_m, sc_m, gt_m, sh_f, sc_f, gt_f = jnp.split(mod, 6, axis=-1)

        h = _rmsnorm(x, g_pre_mix[l]) * (1 + sc_m) + sh_m
        p_r, p_k, p_v, q_att, k_att, v_att, z_a, z_b = _split_cols(h @ w_in[l], PROJ_SIZES)

        y_rwkv = _rwkv7_branch(h, p_r, p_k, p_v, mu_rkv[l], mu_lora[l], w0[l], w1[l], w2[l], a0[l], a1[l],
                               a2[l], g1[l], g2[l], k_k[l], k_a[l], r_k[l], ln_x_w[l], ln_x_b[l], w_o_rwkv[l])

        grp = lambda t: t.reshape(B, T, N_ATTN_GROUPS, ATTN_HEADS_PER_GROUP, ATTN_HEAD)
        qg, kg, vg = grp(q_att), grp(k_att), grp(v_att)
        outs, lses = [], []
        for gi, (window, dilation) in enumerate(ATTN_GROUPS):
            o, lse = _dilated_window_attention(qg[:, :, gi], kg[:, :, gi], vg[:, :, gi], slopes[gi], window, dilation)
            outs.append(o)
            lses.append(lse)
        wts = jax.nn.softmax(jnp.stack(lses), axis=0)
        o = jnp.einsum('gbth,gbthd->bthd', wts, jnp.stack(outs))
        y_attn = o.reshape(B, T, ATTN_OUT).astype(x.dtype) @ w_o_attn[l]

        mixed = (jax.nn.sigmoid(z_a) * y_rwkv + jax.nn.sigmoid(z_b) * y_attn) @ w_out[l]
        x = x + gt_m * _rmsnorm(mixed, g_post_mix[l])

        h = _rmsnorm(x, g_pre_ffn[l]) * (1 + sc_f) + sh_f
        u_gate, u_up = jnp.split(h @ w_ffn_in[l], 2, axis=-1)
        y = (jax.nn.silu(u_gate) * u_up) @ w_ffn_out[l]
        x = x + gt_f * _rmsnorm(y, g_post_ffn[l])
    return x
```

```cpp
#include <hip/hip_runtime.h>
#include <hip/hip_cooperative_groups.h>
#include <cstdio>
#include <cstdint>
namespace cg = cooperative_groups;
namespace pg8 {
#define PG8_LAS __attribute__((address_space(3)))
typedef unsigned short bf16_t;
typedef short bf16x8 __attribute__((ext_vector_type(8)));
typedef float f32x4 __attribute__((ext_vector_type(4)));
typedef unsigned u32x4 __attribute__((ext_vector_type(4)));
constexpr int BM = 256, BK = 64, HALF = 128, HTB = HALF * BK * 2  , STAGE_BYTES = 8 * HTB, NXCD = 8, WGM = 8;

__host__ __device__ __forceinline__ int lds_byte(int r, int c) { const int st = (r >> 4) * 2 + (c >> 5), rr = r & 15, cc = c & 31, ob = rr * 64 + cc * 2; return st * 1024 + (ob ^ (((ob >> 9) & 1) << 5)); }
__host__ __device__ __forceinline__ void stage_rc(int b, int& R, int& C) { const int st = b / 1024, sb = b % 1024, swz = sb ^ (((sb >> 9) & 1) << 5); R = (st >> 1) * 16 + swz / 64; C = (st & 1) * 32 + (swz % 64) / 2; }
__host__ __device__ __forceinline__ int perm32(int rho) { const int n = rho >> 4, i = rho & 15; return 8 * (i >> 2) + 4 * n + (i & 3); }

struct Unit { int pm, pn; };
struct Gemm { const bf16_t* A; const bf16_t* Bt; int M, N, K; };

struct StaticOrder {
    int nM, nN, nwg, G, c;
    __host__ __device__ void init(int M, int N, int G_, int c_) { nM = M / BM; nN = N / BM; nwg = nM * nN; G = G_; c = c_; }
    __host__ __device__ bool next(int i, Unit& u) const {
        const long L = (long)i * G + c; if (L >= nwg) return false;
        int wgid = (int)L; { const int q = nwg / NXCD, r = nwg % NXCD, xcd = wgid % NXCD, off = wgid / NXCD; wgid = (xcd < r ? xcd * (q + 1) : r * (q + 1) + (xcd - r) * q) + off; }
        const int nig = WGM * nN, gid = wgid / nig, fm = gid * WGM, gsz = (nM - fm) < WGM ? (nM - fm) : WGM;
        u.pm = fm + ((wgid % nig) % gsz); u.pn = (wgid % nig) / gsz; return true;
    }
    __device__ __forceinline__ void a_ready(const Unit&) const {}
    __device__ __forceinline__ void done(const Unit&) const {}
};
__device__ __forceinline__ unsigned cvt_pk_bf16(float lo, float hi) { unsigned r; asm volatile("v_cvt_pk_bf16_f32 %0, %1, %2" : "=v"(r) : "v"(lo), "v"(hi)); return r; }
template <class Epi, class Sched, bool ALIGN_EPI = false, bool SP2 = false>
__device__ __forceinline__ void gemm_phase(PG8_LAS unsigned char* lds, const Gemm g, const Sched& S, const Epi& E) {
    const int tid = threadIdx.x, wid = __builtin_amdgcn_readfirstlane(tid >> 6), lane = tid & 63, wr = wid >> 2, wc = wid & 3, fr = lane & 15, fq = lane >> 4;
    const int K = g.K, nt = K / BK;
    unsigned voffA[2], voffB[2];
#pragma unroll
    for (int i = 0; i < 2; ++i) { int R, C; stage_rc(tid * 16 + i * 8192, R, C); const int Rb = Epi::PERM ? ((R & ~31) + perm32(R & 31)) : R;
        voffA[i] = (unsigned)(R * K + C) * 2u; voffB[i] = (unsigned)(Rb * K + C) * 2u; }
    const size_t kstep = (size_t)(BK * 2);
    const size_t hstep = (size_t)HALF * K * 2;
    const size_t tstep = 2 * hstep;
    const unsigned ldsw = (unsigned)wid * 1024u;
    const int aoff = lds_byte(wr * 64 + fr, fq * 8), boff = lds_byte(wc * 32 + fr, fq * 8);
#define PG8_SA(b, h) (((b) * 2 + (h)) * HTB)
#define PG8_SB(b, h) ((4 + (b) * 2 + (h)) * HTB)
#define PG8_STAGE(bufoff, gbase, voff) do { _Pragma("unroll") for (int _i = 0; _i < 2; ++_i) \
        __builtin_amdgcn_global_load_lds((const unsigned*)((const char*)(gbase) + (voff)[_i]), (PG8_LAS unsigned*)(lds + (bufoff) + ldsw + _i * 8192), 16, 0, 0); } while (0)
#define PG8_LDA(dst, b, h) do { _Pragma("unroll") for (int m = 0; m < 4; ++m) _Pragma("unroll") for (int k = 0; k < 2; ++k) dst[m][k] = *(const PG8_LAS bf16x8*)(lds + PG8_SA(b, h) + aoff + m * 2048 + k * 1024); } while (0)
#define PG8_LDB(dst, b, h) do { _Pragma("unroll") for (int n = 0; n < 2; ++n) _Pragma("unroll") for (int k = 0; k < 2; ++k) dst[n][k] = *(const PG8_LAS bf16x8*)(lds + PG8_SB(b, h) + boff + n * 2048 + k * 1024); } while (0)
#define PG8_MMA(ai, bj, At, Bt) do { __builtin_amdgcn_s_setprio(1); _Pragma("unroll") for (int m = 0; m < 4; ++m) _Pragma("unroll") for (int n = 0; n < 2; ++n) _Pragma("unroll") for (int k = 0; k < 2; ++k) \
        acc[ai][bj][m][n] = __builtin_amdgcn_mfma_f32_16x16x32_bf16(Bt[n][k], At[m][k], acc[ai][bj][m][n], 0, 0, 0); __builtin_amdgcn_s_setprio(0); } while (0)
#define PG8_WAIT_V(n) asm volatile("s_waitcnt vmcnt(" #n ")" ::: "memory")
#define PG8_WAIT_L(n) asm volatile("s_waitcnt lgkmcnt(" #n ")" ::: "memory")
#define PG8_BAR __builtin_amdgcn_s_barrier()
#define PG8_SCHED __builtin_amdgcn_sched_barrier(0)
    Unit cur, nxt; int ui = 0;
    if (!S.next(0, cur)) return;
    f32x4 acc[2][2][4][2];
#pragma unroll
    for (int a = 0; a < 2; ++a)
#pragma unroll
        for (int b = 0; b < 2; ++b)
#pragma unroll
            for (int m = 0; m < 4; ++m)
#pragma unroll
                for (int n = 0; n < 2; ++n) acc[a][b][m][n] = (f32x4){0.f, 0.f, 0.f, 0.f};
    bf16x8 At[4][2], B0[2][2], B1[2][2];
    const char* cA = (const char*)g.A + (size_t)cur.pm * tstep; const char* cB = (const char*)g.Bt + (size_t)cur.pn * tstep;
    S.a_ready(cur);
    if constexpr (SP2) {
        PG8_STAGE(PG8_SB(0, 0), cB, voffB); PG8_STAGE(PG8_SB(0, 1), cB + hstep, voffB); PG8_STAGE(PG8_SA(0, 0), cA, voffA); PG8_STAGE(PG8_SA(0, 1), cA + hstep, voffA);
        if (wr == 1) PG8_BAR;
        PG8_WAIT_V(2); PG8_BAR;
        PG8_STAGE(PG8_SB(1, 0), cB + kstep, voffB); PG8_STAGE(PG8_SA(1, 0), cA + kstep, voffA); PG8_STAGE(PG8_SB(1, 1), cB + hstep + kstep, voffB);
        PG8_WAIT_V(6); PG8_BAR;
    } else {
        PG8_STAGE(PG8_SB(0, 0), cB, voffB); PG8_STAGE(PG8_SA(0, 0), cA, voffA); PG8_STAGE(PG8_SB(0, 1), cB + hstep, voffB); PG8_STAGE(PG8_SA(0, 1), cA + hstep, voffA);
        if (wr == 1) PG8_BAR;
        PG8_WAIT_V(4); PG8_BAR;
        PG8_STAGE(PG8_SB(1, 0), cB + kstep, voffB); PG8_STAGE(PG8_SA(1, 0), cA + kstep, voffA); PG8_STAGE(PG8_SB(1, 1), cB + hstep + kstep, voffB);
        PG8_WAIT_V(6); PG8_BAR;
    }
    for (;;) {
        const bool has_next = S.next(ui + 1, nxt);
        const char* nA = has_next ? (const char*)g.A + (size_t)nxt.pm * tstep : cA; const char* nB = has_next ? (const char*)g.Bt + (size_t)nxt.pn * tstep : cB;
#pragma nounroll
        for (int t = 0; t < nt; t += 2) {
            const bool last = (t == nt - 2);
            const char* a1 = cA + (size_t)(t + 1) * kstep;
            const char* a2 = last ? nA : cA + (size_t)(t + 2) * kstep; const char* b2 = last ? nB : cB + (size_t)(t + 2) * kstep;
            const char* a3 = a2 + kstep; const char* b3 = b2 + kstep;
            if (last && has_next) S.a_ready(nxt);
            if constexpr (SP2) {
            PG8_LDB(B0, 0, 0); PG8_LDB(B1, 0, 1); PG8_SCHED; PG8_LDA(At, 0, 0); PG8_STAGE(PG8_SA(1, 1), a1 + hstep, voffA);
            PG8_WAIT_V(8); PG8_WAIT_L(0); PG8_BAR; PG8_MMA(0, 0, At, B0); PG8_MMA(0, 1, At, B1); PG8_BAR; PG8_SCHED;
            PG8_LDA(At, 0, 1); PG8_STAGE(PG8_SB(0, 0), b2, voffB); PG8_STAGE(PG8_SB(0, 1), b2 + hstep, voffB); PG8_STAGE(PG8_SA(0, 0), a2, voffA);
            PG8_WAIT_V(8); PG8_WAIT_L(0); PG8_BAR; PG8_MMA(1, 0, At, B0); PG8_MMA(1, 1, At, B1); PG8_BAR; PG8_SCHED;
            PG8_LDB(B0, 1, 0); PG8_LDB(B1, 1, 1); PG8_SCHED; PG8_LDA(At, 1, 0); PG8_STAGE(PG8_SA(0, 1), a2 + hstep, voffA);
            PG8_WAIT_V(8); PG8_WAIT_L(0); PG8_BAR; PG8_MMA(0, 0, At, B0); PG8_MMA(0, 1, At, B1); PG8_BAR; PG8_SCHED;
            PG8_LDA(At, 1, 1); PG8_STAGE(PG8_SB(1, 0), b3, voffB); PG8_STAGE(PG8_SB(1, 1), b3 + hstep, voffB); PG8_STAGE(PG8_SA(1, 0), a3, voffA);
            PG8_WAIT_V(8); PG8_WAIT_L(0); PG8_BAR; PG8_MMA(1, 0, At, B0); PG8_MMA(1, 1, At, B1); PG8_BAR; PG8_SCHED;
            } else {
            PG8_LDB(B0, 0, 0); PG8_SCHED; PG8_LDA(At, 0, 0); PG8_STAGE(PG8_SA(1, 1), a1 + hstep, voffA);
            PG8_WAIT_L(8); PG8_BAR; PG8_WAIT_L(0); PG8_MMA(0, 0, At, B0); PG8_BAR; PG8_SCHED;
            PG8_LDB(B1, 0, 1); PG8_STAGE(PG8_SB(0, 0), b2, voffB);
            PG8_BAR; PG8_WAIT_L(0); PG8_MMA(0, 1, At, B1); PG8_BAR;
            PG8_LDA(At, 0, 1); PG8_STAGE(PG8_SA(0, 0), a2, voffA);
            PG8_BAR; PG8_WAIT_L(0); PG8_MMA(1, 0, At, B0); PG8_BAR; PG8_SCHED;
            PG8_STAGE(PG8_SB(0, 1), b2 + hstep, voffB);
            PG8_WAIT_V(6); PG8_BAR; PG8_MMA(1, 1, At, B1); PG8_BAR;
            PG8_LDB(B0, 1, 0); PG8_SCHED; PG8_LDA(At, 1, 0); PG8_STAGE(PG8_SA(0, 1), a2 + hstep, voffA);
            PG8_WAIT_L(8); PG8_BAR; PG8_WAIT_L(0); PG8_MMA(0, 0, At, B0); PG8_BAR; PG8_SCHED;
            PG8_LDB(B1, 1, 1); PG8_STAGE(PG8_SB(1, 0), b3, voffB);
            PG8_BAR; PG8_WAIT_L(0); PG8_MMA(0, 1, At, B1); PG8_BAR;
            PG8_LDA(At, 1, 1); PG8_STAGE(PG8_SA(1, 0), a3, voffA);
            PG8_BAR; PG8_WAIT_L(0); PG8_MMA(1, 0, At, B0); PG8_BAR; PG8_SCHED;
            PG8_STAGE(PG8_SB(1, 1), b3 + hstep, voffB);
            PG8_WAIT_V(6); PG8_BAR; PG8_MMA(1, 1, At, B1); PG8_BAR;
            }
        }
        if constexpr (ALIGN_EPI) { if (wr == 0) PG8_BAR; }
        if constexpr (!Epi::AFTER_DRAIN) { E(acc, cur, wr, wc, fr, fq); S.done(cur); }
        if (!has_next) break;
#pragma unroll
        for (int a = 0; a < 2; ++a)
#pragma unroll
            for (int b = 0; b < 2; ++b)
#pragma unroll
                for (int m = 0; m < 4; ++m)
#pragma unroll
                    for (int n = 0; n < 2; ++n) acc[a][b][m][n] = (f32x4){0.f, 0.f, 0.f, 0.f};
        cur = nxt; cA = nA; cB = nB; ++ui;
        if constexpr (ALIGN_EPI) { if (wr == 1) PG8_BAR; }
    }
    PG8_WAIT_V(0);
    if constexpr (!ALIGN_EPI) { if (wr == 0) PG8_BAR; }
    PG8_BAR;
    if constexpr (Epi::AFTER_DRAIN) { E.fused(acc, cur, wr, wc, fr, fq, lds, wid, lane); S.done(cur); }
#undef PG8_SA
#undef PG8_SB
#undef PG8_STAGE
#undef PG8_LDA
#undef PG8_LDB
#undef PG8_MMA
#undef PG8_WAIT_V
#undef PG8_WAIT_L
#undef PG8_BAR
#undef PG8_SCHED
}
}

typedef unsigned short bf16_t;
using pg8::f32x4; using pg8::bf16x8; using pg8::u32x4; using pg8::cvt_pk_bf16;
typedef short s16x4 __attribute__((ext_vector_type(4)));
typedef unsigned u32x2 __attribute__((ext_vector_type(2)));
#define LAS __attribute__((address_space(3)))
constexpr int NB = 4, T = 8192, D = 1024, M = NB * T, NTHR = 512;
constexpr size_t MiB = 1u << 20;
constexpr size_t WS_MOD = 0, WS_BAR = 512 * 1024, WS_BONUS = 1 * MiB, WS_WA = 3 * MiB, WS_WB = 12 * MiB, WS_WC = 20 * MiB, WS_W2 = 24 * MiB, WS_WOR = 27 * MiB, WS_WOA = 29 * MiB,
                 WS_WOUT = 30 * MiB, WS_WFI = 32 * MiB, WS_WFO = 43 * MiB;
constexpr size_t WS_HB = 50 * MiB, WS_QKVA = 114 * MiB, WS_OATT = 442 * MiB;
constexpr size_t WS_PRKV = 114 * MiB, WS_P = 306 * MiB, WS_A2 = 354 * MiB, WS_WLOG = 378 * MiB, WS_Y = 306 * MiB;
constexpr size_t WS_T1 = 242 * MiB, WS_MIXIN = 114 * MiB, WS_MIXED = 378 * MiB;
constexpr size_t WS_U = 114 * MiB, WS_Y2 = 290 * MiB, WS_END = 512 * MiB;
constexpr size_t OUT_OG = 0, OUT_LSE = 96 * MiB, OUT_ASIG = 0, OUT_GG = 64 * MiB;
constexpr int LDS_BYTES = 147456;
constexpr int NPHASE = 18;

struct Args { const float* in[29]; float* out; unsigned char* ws; int ph_lo, ph_hi; };

__device__ __forceinline__ float bf2f(bf16_t v) { return __uint_as_float(((unsigned)v) << 16); }
__device__ __forceinline__ bf16_t f2bf(float f) { unsigned u = __float_as_uint(f); u += 0x7FFFu + ((u >> 16) & 1u); return (bf16_t)(u >> 16); }
__device__ __forceinline__ float lo_bf(unsigned u) { return __uint_as_float(u << 16); }
__device__ __forceinline__ float hi_bf(unsigned u) { return __uint_as_float(u & 0xffff0000u); }
__device__ __forceinline__ float sigmoidf_(float x) { return __builtin_amdgcn_rcpf(1.0f + __expf(-x)); }
__device__ __forceinline__ float wave_sum(float v) {
#pragma unroll
    for (int o = 32; o >= 1; o >>= 1) v += __shfl_xor(v, o);
    return v;
}
__device__ __forceinline__ unsigned pk_f16(float a, float b) {
    const _Float16 ha = (_Float16)a, hb = (_Float16)b;
    return (unsigned)__builtin_bit_cast(unsigned short, ha) | ((unsigned)__builtin_bit_cast(unsigned short, hb) << 16);
}
__device__ __forceinline__ float f16_to_f(unsigned short h) { return (float)__builtin_bit_cast(_Float16, h); }

enum { EP_PLAIN = 0, EP_SPLIT = 1, EP_L2W = 2, EP_SIG = 3, EP_MULG = 4, EP_MIX = 5, EP_SWIGLU = 6, EP_L2A = 7, EP_L2 = 8, EP_QKV = 9 };
template <int MODE> struct Epi {
    static constexpr bool PERM = true, AFTER_DRAIN = false;
    bf16_t* O; int ldc; bf16_t* O2; bf16_t* O3; const bf16_t* G; const bf16_t* G2; const float* v0; const float* v1;
    __device__ __forceinline__ void operator()(const f32x4 (&acc)[2][2][4][2], const pg8::Unit& u, int wr, int wc, int fr, int fq) const {
        const int row0 = u.pm * 256 + wr * 64 + fr, cin = wc * 32 + 8 * fq;
#pragma unroll
        for (int ai = 0; ai < 2; ++ai)
#pragma unroll
            for (int m = 0; m < 4; ++m) {
                const size_t row = (size_t)(row0 + ai * 128 + m * 16);
                if constexpr (MODE == EP_SWIGLU) {
                    const f32x4 g0 = acc[ai][0][m][0], g1 = acc[ai][0][m][1], u0 = acc[ai][1][m][0], u1 = acc[ai][1][m][1];
                    float r[8];
#pragma unroll
                    for (int j = 0; j < 4; ++j) { r[j] = g0[j] * sigmoidf_(g0[j]) * u0[j]; r[4 + j] = g1[j] * sigmoidf_(g1[j]) * u1[j]; }
                    u32x4 w; w.x = cvt_pk_bf16(r[0], r[1]); w.y = cvt_pk_bf16(r[2], r[3]); w.z = cvt_pk_bf16(r[4], r[5]); w.w = cvt_pk_bf16(r[6], r[7]);
                    *(u32x4*)(O + row * ldc + u.pn * 128 + cin) = w;
                } else {
#pragma unroll
                    for (int bj = 0; bj < 2; ++bj) {
                        const int col = u.pn * 256 + bj * 128 + cin;
                        const f32x4 a0 = acc[ai][bj][m][0], a1 = acc[ai][bj][m][1];
                        float r[8] = {a0[0], a0[1], a0[2], a0[3], a1[0], a1[1], a1[2], a1[3]};
                        bf16_t* dst = O + row * ldc + col;
                        if constexpr (MODE == EP_SPLIT) { if (col >= 3072) dst = O2 + row * 768 + (col - 3072); }
                        if constexpr (MODE == EP_QKV) {
                            const int sg = u.pn >> 1, g = sg % 3, hh = (u.pn & 1) * 4 + ((bj * 128 + cin) >> 6), dd = cin & 63;
                            const int bb = (int)(row >> 13), t = (int)row & (T - 1), dsh = 2 * g, r = t & ((1 << dsh) - 1), uu = t >> dsh;
                            dst = O + ((((size_t)(sg * 8 + hh) * 4 + bb) * T + (size_t)r * (T >> dsh) + uu) << 6) + dd;
                        }
                        if constexpr (MODE == EP_SIG) {
#pragma unroll
                            for (int j = 0; j < 8; ++j) r[j] = sigmoidf_(r[j]);
                            dst = (col < 1024) ? (O + row * 1024 + col) : (O2 + row * 1024 + (col - 1024));
                        }
                        if constexpr (MODE == EP_MULG) {
                            const u32x4 gv = *(const u32x4*)(G + row * 1024 + col);
                            r[0] *= lo_bf(gv.x); r[1] *= hi_bf(gv.x); r[2] *= lo_bf(gv.y); r[3] *= hi_bf(gv.y); r[4] *= lo_bf(gv.z); r[5] *= hi_bf(gv.z); r[6] *= lo_bf(gv.w); r[7] *= hi_bf(gv.w);
                        }
                        if constexpr (MODE == EP_MIX) {
                            const u32x4 gv = *(const u32x4*)(G + row * 1024 + col);
                            const u32x4 tv = *(const u32x4*)(G2 + row * 1024 + col);
                            r[0] = lo_bf(tv.x) + r[0] * lo_bf(gv.x); r[1] = hi_bf(tv.x) + r[1] * hi_bf(gv.x); r[2] = lo_bf(tv.y) + r[2] * lo_bf(gv.y); r[3] = hi_bf(tv.y) + r[3] * hi_bf(gv.y);
                            r[4] = lo_bf(tv.z) + r[4] * lo_bf(gv.z); r[5] = hi_bf(tv.z) + r[5] * hi_bf(gv.z); r[6] = lo_bf(tv.w) + r[6] * lo_bf(gv.w); r[7] = hi_bf(tv.w) + r[7] * hi_bf(gv.w);
                        }
                        if constexpr (MODE == EP_L2) {
                            const int region = u.pn >> 2, cc = col - 1024 * region;
                            if (region == 0) {
                                const f32x4 b0 = *(const f32x4*)(v0 + cc), b1 = *(const f32x4*)(v0 + cc + 4);
                                const float z[8] = {b0[0], b0[1], b0[2], b0[3], b1[0], b1[1], b1[2], b1[3]};
#pragma unroll
                                for (int j = 0; j < 8; ++j) r[j] = 1.0f - __expf(-0.6065306597126334f * sigmoidf_(z[j] + r[j]));
                                u32x4 w; w.x = pk_f16(r[0], r[1]); w.y = pk_f16(r[2], r[3]); w.z = pk_f16(r[4], r[5]); w.w = pk_f16(r[6], r[7]);
                                *(u32x4*)(O + row * 1024 + cc) = w;
                                continue;
                            } else if (region == 1) {
                                const f32x4 b0 = *(const f32x4*)(v1 + cc), b1 = *(const f32x4*)(v1 + cc + 4);
                                const float z[8] = {b0[0], b0[1], b0[2], b0[3], b1[0], b1[1], b1[2], b1[3]};
#pragma unroll
                                for (int j = 0; j < 8; ++j) r[j] = sigmoidf_(z[j] + r[j]);
                                dst = O2 + row * 1024 + cc;
                            } else dst = O3 + row * 1024 + cc;
                        }
                        if constexpr (MODE == EP_L2W) {
                            const f32x4 b0 = *(const f32x4*)(v0 + col), b1 = *(const f32x4*)(v0 + col + 4);
                            const float z[8] = {b0[0], b0[1], b0[2], b0[3], b1[0], b1[1], b1[2], b1[3]};
#pragma unroll
                            for (int j = 0; j < 8; ++j) r[j] = 1.0f - __expf(-0.6065306597126334f * sigmoidf_(z[j] + r[j]));
                            u32x4 w; w.x = pk_f16(r[0], r[1]); w.y = pk_f16(r[2], r[3]); w.z = pk_f16(r[4], r[5]); w.w = pk_f16(r[6], r[7]);
                            *(u32x4*)dst = w;
                            continue;
                        }
                        if constexpr (MODE == EP_L2A) {
                            const f32x4 b0 = *(const f32x4*)(v0 + col), b1 = *(const f32x4*)(v0 + col + 4);
                            const float z[8] = {b0[0], b0[1], b0[2], b0[3], b1[0], b1[1], b1[2], b1[3]};
#pragma unroll
                            for (int j = 0; j < 8; ++j) r[j] = sigmoidf_(z[j] + r[j]);
                        }
                        u32x4 w; w.x = cvt_pk_bf16(r[0], r[1]); w.y = cvt_pk_bf16(r[2], r[3]); w.z = cvt_pk_bf16(r[4], r[5]); w.w = cvt_pk_bf16(r[6], r[7]);
                        *(u32x4*)dst = w;
                    }
                }
            }
    }
};
template <int MODE> __device__ __forceinline__ void run_gemm(LAS unsigned char* lds, const bf16_t* A, const bf16_t* Bt, int N, int K, const Epi<MODE>& E) {
    pg8::Gemm g{A, Bt, M, N, K}; pg8::StaticOrder S; S.init(M, N, (int)gridDim.x, (int)blockIdx.x);
    pg8::gemm_phase<Epi<MODE>, pg8::StaticOrder, true, true>(lds, g, S, E);
}

#define XB_TMO      128
#define XB_XCNT(j)  (256  + 64 * (j))
#define XB_XSUB(j)  (1280 + 64 * (j))
#define XB_XGEN(j)  (2304 + 64 * (j))
#define XB_TOP      3328
#define XB_TOPGEN   3392
#define XCD_BAR_WORDS 3456
#define XB_SPIN_CAP (1u << 18)

__device__ __forceinline__ unsigned xb_ld(unsigned* p)              { return __hip_atomic_load(p, __ATOMIC_RELAXED, __HIP_MEMORY_SCOPE_AGENT); }
__device__ __forceinline__ unsigned xb_add(unsigned* p, unsigned v) { return __hip_atomic_fetch_add(p, v, __ATOMIC_RELAXED, __HIP_MEMORY_SCOPE_AGENT); }
__device__ __forceinline__ unsigned xb_xcc_id() { return (unsigned)__builtin_amdgcn_s_getreg((3 << 11) | 20) & 0xFu; }
#define XB_SPIN(cond, bar) do { unsigned _sp = 0; while (cond) { __builtin_amdgcn_s_sleep(1); \
    if ((++_sp & 255u) == 0u) { if (xb_ld(&(bar)[XB_TMO])) break; if (_sp > XB_SPIN_CAP) { atomicAdd(&(bar)[XB_TMO], 1u); break; } } } } while (0)

struct XcdBarrier {
    unsigned* bar; unsigned x;
    volatile LAS unsigned* st;
};

__device__ __forceinline__ XcdBarrier xcd_barrier_post(unsigned* bar, volatile LAS unsigned* st) {
    XcdBarrier b; b.bar = bar; b.x = xb_xcc_id(); b.st = st;
    if (threadIdx.x == 0) (void)xb_add(&bar[XB_XCNT(b.x)], 1u);
    return b;
}
__device__ __forceinline__ void xcd_barrier_complete(unsigned* bar, unsigned x, unsigned& nloc, unsigned& nx) {
    const unsigned G = gridDim.x * gridDim.y * gridDim.z;
    unsigned sum, cnt, mine, sp = 0u;
    for (;;) {
        sum = 0u; cnt = 0u; mine = 0u;
#pragma unroll
        for (unsigned j = 0; j < 16; ++j) { const unsigned c = xb_ld(&bar[XB_XCNT(j)]); sum += c; cnt += (c > 0u) ? 1u : 0u; mine = (j == x) ? c : mine; }
        if (sum == G) break;
        __builtin_amdgcn_s_sleep(1);
        if ((++sp & 255u) == 0u) { if (xb_ld(&bar[XB_TMO])) break; if (sp > XB_SPIN_CAP) { atomicAdd(&bar[XB_TMO], 1u); break; } }
    }
    nloc = mine > 0u ? mine : 1u; nx = cnt > 0u ? cnt : 1u;
}

__device__ __forceinline__ void xcd_barrier(const XcdBarrier& b) {
    asm volatile("s_waitcnt vmcnt(0)" ::: "memory");
    __syncthreads();
    if (threadIdx.x == 0) {
        unsigned* bar = b.bar;
        __builtin_amdgcn_s_waitcnt(0);
        unsigned nloc = b.st[0], nx = b.st[1];
        if (nloc == 0u) { xcd_barrier_complete(bar, b.x, nloc, nx); b.st[0] = nloc; b.st[1] = nx; }
        const unsigned old = xb_add(&bar[XB_XSUB(b.x)], 1u);
        const unsigned gen = old / nloc;
        if (old + 1u == (gen + 1u) * nloc) {
            __builtin_amdgcn_fence(__ATOMIC_RELEASE, "agent");
            asm volatile("s_waitcnt vmcnt(0)" ::: "memory");
            const unsigned og = xb_add(&bar[XB_TOP], 1u);
            const unsigned tg = og / nx;
            if (og + 1u == (tg + 1u) * nx) xb_add(&bar[XB_TOPGEN], 1u);
            else XB_SPIN(xb_ld(&bar[XB_TOPGEN]) == tg, bar);
            __builtin_amdgcn_fence(__ATOMIC_ACQUIRE, "agent");
            xb_add(&bar[XB_XGEN(b.x)], 1u);
            asm volatile("s_waitcnt vmcnt(0)" ::: "memory");
        } else {
            XB_SPIN(xb_ld(&bar[XB_XGEN(b.x)]) == gen, bar);
            __builtin_amdgcn_fence(__ATOMIC_ACQUIRE, "agent");
            asm volatile("s_waitcnt vmcnt(0)" ::: "memory");
        }
    }
    __syncthreads();
}


constexpr int TRP = 129;
struct TrJob { const float* src; int ld, c0, ncols, K; bf16_t* dst; int ldd, drow0, dk0; const float* rs; int rsmode; float cscale; };
__device__ __forceinline__ void tile_load(const TrJob& j, int t, float (&v)[16]) {
    const int tid = threadIdx.x, cc = tid & 127, kb = tid >> 7;
    const int nct = (j.ncols + 127) >> 7, ct = t % nct, k0 = (t / nct) * 64;
    int nc = j.ncols - ct * 128; if (nc > 128) nc = 128;
    const float* s = j.src + j.c0 + ct * 128 + cc;
#pragma unroll
    for (int p = 0; p < 16; ++p) { const int kk = k0 + kb + 4 * p; v[p] = (kk < j.K && cc < nc) ? s[(size_t)kk * j.ld] : 0.f; }
    if (j.rs) {
#pragma unroll
        for (int p = 0; p < 16; ++p) { const int kk = k0 + kb + 4 * p; if (kk < j.K) { const float mu = j.rs[kk]; v[p] *= j.rsmode ? mu : (1.0f - mu); } }
    }
}
__device__ __forceinline__ void tile_finish(LAS float* tile, const TrJob& j, int t, const float (&v)[16]) {
    const int tid = threadIdx.x, cc = tid & 127, kb = tid >> 7;
    const int nct = (j.ncols + 127) >> 7, ct = t % nct, k0 = (t / nct) * 64;
    int nc = j.ncols - ct * 128; if (nc > 128) nc = 128;
    __syncthreads();
#pragma unroll
    for (int p = 0; p < 16; ++p) tile[(kb + 4 * p) * TRP + cc] = v[p] * j.cscale;
    __syncthreads();
    const int n = tid >> 2, ks = tid & 3;
    if (n < nc) {
#pragma unroll
        for (int hf = 0; hf < 2; ++hf) {
            const int kq = ks * 16 + hf * 8;
            if (k0 + kq < j.K) {
                float r[8];
#pragma unroll
                for (int q = 0; q < 8; ++q) r[q] = tile[(kq + q) * TRP + n];
                u32x4 w; w.x = cvt_pk_bf16(r[0], r[1]); w.y = cvt_pk_bf16(r[2], r[3]); w.z = cvt_pk_bf16(r[4], r[5]); w.w = cvt_pk_bf16(r[6], r[7]);
                *(u32x4*)(j.dst + (size_t)(j.drow0 + ct * 128 + n) * j.ldd + j.dk0 + k0 + kq) = w;
            }
        }
    }
}
constexpr int NTILES = 2760;
__device__ __forceinline__ void tile_decode(const Args& a, int g, TrJob& j, int& t) {
    unsigned char* ws = a.ws; const float* w_in = a.in[8]; const float* mu = a.in[10];
    bf16_t* WA = (bf16_t*)(ws + WS_WA); bf16_t* WB = (bf16_t*)(ws + WS_WB); bf16_t* W2 = (bf16_t*)(ws + WS_W2);
    const float QS = 0.125f * 1.4426950408889634f;
    if (g < 192) { j = TrJob{w_in, 9728, 3072, 1536, 1024, WA, 1024, 0, 0, nullptr, 0, QS}; t = g; return; } g -= 192;
    if (g < 384) { j = TrJob{w_in, 9728, 4608, 3072, 1024, WA, 1024, 1536, 0, nullptr, 0, 1.0f}; t = g; return; } g -= 384;
    if (g < 384) { j = TrJob{w_in, 9728, 0, 3072, 1024, WB, 1024, 0, 0, nullptr, 0, 1.0f}; t = g; return; } g -= 384;
    if (g < 16) { j = TrJob{a.in[12], 64, 0, 64, 1024, WB, 1024, 3072, 0, mu, 0, 1.0f}; t = g; return; } g -= 16;
    if (g < 16) { j = TrJob{a.in[15], 64, 0, 64, 1024, WB, 1024, 3136, 0, mu + 1024, 0, 1.0f}; t = g; return; } g -= 16;
    if (g < 32) { j = TrJob{a.in[17], 160, 0, 160, 1024, WB, 1024, 3200, 0, mu + 2048, 0, 1.0f}; t = g; return; } g -= 32;
    if (g < 16) { j = TrJob{a.in[12], 64, 0, 64, 1024, WB, 1024, 3360, 0, mu, 1, 1.0f}; t = g; return; } g -= 16;
    if (g < 16) { j = TrJob{a.in[15], 64, 0, 64, 1024, WB, 1024, 3424, 0, mu + 1024, 1, 1.0f}; t = g; return; } g -= 16;
    if (g < 32) { j = TrJob{a.in[17], 160, 0, 160, 1024, WB, 1024, 3488, 0, mu + 2048, 1, 1.0f}; t = g; return; } g -= 32;
    if (g < 256) { j = TrJob{w_in, 9728, 7680, 2048, 1024, (bf16_t*)(ws + WS_WC), 1024, 0, 0, nullptr, 0, 1.0f}; t = g; return; } g -= 256;
    if (g < 128) { j = TrJob{a.in[24], 1024, 0, 1024, 1024, (bf16_t*)(ws + WS_WOR), 1024, 0, 0, nullptr, 0, 1.0f}; t = g; return; } g -= 128;
    if (g < 64) { j = TrJob{a.in[25], 1024, 0, 1024, 512, (bf16_t*)(ws + WS_WOA), 512, 0, 0, nullptr, 0, 1.0f}; t = g; return; } g -= 64;
    if (g < 128) { j = TrJob{a.in[26], 1024, 0, 1024, 1024, (bf16_t*)(ws + WS_WOUT), 1024, 0, 0, nullptr, 0, 1.0f}; t = g; return; } g -= 128;
    if (g < 352) { j = TrJob{a.in[28], 1024, 0, 1024, 2816, (bf16_t*)(ws + WS_WFO), 2816, 0, 0, nullptr, 0, 1.0f}; t = g; return; } g -= 352;
    if (g < 704) { const int s = g >> 4, pn = s >> 1, bj = s & 1;
                   j = TrJob{a.in[27], 5632, bj * 2816 + pn * 128, 128, 1024, (bf16_t*)(ws + WS_WFI), 1024, pn * 256 + bj * 128, 0, nullptr, 0, 1.0f}; t = g & 15; return; } g -= 704;
    if (g < 8) { j = TrJob{a.in[13], 1024, 0, 1024, 64, W2, 384, 0, 0, nullptr, 0, 1.0f}; t = g; return; } g -= 8;
    if (g < 8) { j = TrJob{a.in[16], 1024, 0, 1024, 64, W2, 384, 1024, 64, nullptr, 0, 1.0f}; t = g; return; } g -= 8;
    j = TrJob{a.in[18], 1024, 0, 1024, 160, W2, 384, 2048, 128, nullptr, 0, 1.0f}; t = g;
}
__device__ __forceinline__ void p0_prologue(const Args& a, LAS unsigned char* lds) {
    LAS float* tile = (LAS float*)lds;
    unsigned char* ws = a.ws;
    const int tid = threadIdx.x, G = gridDim.x, bx = blockIdx.x;
    const float* w_in = a.in[8]; const float* mu_lora = a.in[10];
    bf16_t* WA = (bf16_t*)(ws + WS_WA); bf16_t* WB = (bf16_t*)(ws + WS_WB); bf16_t* WC = (bf16_t*)(ws + WS_WC); bf16_t* W2 = (bf16_t*)(ws + WS_W2);
    {
        const float* c = a.in[1]; const float* w_mod = a.in[2]; const float* b_mod = a.in[3];
        float* MOD = (float*)(ws + WS_MOD);
        LAS float* red = (LAS float*)lds;
        for (int cb = bx; cb < 256; cb += G) {
            const int col = tid % 24, kg = tid / 24;
            float s0 = 0.f, s1 = 0.f, s2 = 0.f, s3 = 0.f;
            if (kg < 21)
#pragma unroll 7
            for (int k = kg; k < 1024; k += 21) { const float w = w_mod[(size_t)k * 6144 + cb * 24 + col]; s0 += c[k] * w; s1 += c[1024 + k] * w; s2 += c[2048 + k] * w; s3 += c[3072 + k] * w; }
            __syncthreads();
            if (kg < 21) { red[(kg * 24 + col) * 4 + 0] = s0; red[(kg * 24 + col) * 4 + 1] = s1; red[(kg * 24 + col) * 4 + 2] = s2; red[(kg * 24 + col) * 4 + 3] = s3; }
            __syncthreads();
            if (tid < 96) { const int cc = tid % 24, b = tid / 24; float s = 0.f; for (int g = 0; g < 21; ++g) s += red[(g * 24 + cc) * 4 + b]; MOD[b * 6144 + cb * 24 + cc] = s + b_mod[cb * 24 + cc]; }
        }
        __syncthreads();
    }
    {
        int g = bx, t = 0, tn = 0; TrJob j{}, jn{}; float v[16], vn[16];
        if (g < NTILES) { tile_decode(a, g, j, t); tile_load(j, t, v); }
        while (g < NTILES) {
            const int gn = g + G;
            if (gn < NTILES) { tile_decode(a, gn, jn, tn); tile_load(jn, tn, vn); }
            tile_finish(tile, j, t, v);
            j = jn; t = tn; g = gn;
#pragma unroll
            for (int p2 = 0; p2 < 16; ++p2) v[p2] = vn[p2];
        }
    }
    for (int i = bx * NTHR + tid; i < 192 * 1024 / 8; i += G * NTHR) ((u32x4*)(WB + (size_t)3648 * 1024))[i] = (u32x4){0u, 0u, 0u, 0u};
    for (int i = bx * NTHR + tid; i < 1024 * 108; i += G * NTHR) {
        const int row = i / 108, c = i % 108;
        int n, k8;
        if (c < 40) { n = row; k8 = 8 + c; }
        else if (c < 80) { n = 1024 + row; k8 = (c - 40) < 8 ? (c - 40) : (c - 40) + 8; }
        else { n = 2048 + row; k8 = (c - 80) < 16 ? (c - 80) : (c - 80) + 20; }
        *(u32x4*)(W2 + (size_t)n * 384 + k8 * 8) = (u32x4){0u, 0u, 0u, 0u};
    }
}

constexpr int RPW = 16;
__device__ __forceinline__ void p1_prenorm(const Args& a) {
    const int lane = threadIdx.x & 63, wave = threadIdx.x >> 6;
    const float* x = a.in[0]; const float* gpre = a.in[4]; const float* MOD = (const float*)(a.ws + WS_MOD); bf16_t* HB = (bf16_t*)(a.ws + WS_HB);
    for (int base = (blockIdx.x * 8 + wave) * RPW; base < M; base += gridDim.x * 8 * RPW) {
        const float* mod = MOD + (base / T) * 6144;
        f32x4 g[4], sh[4], sc[4];
#pragma unroll
        for (int i = 0; i < 4; ++i) { const int c = i * 256 + lane * 4; g[i] = *(const f32x4*)(gpre + c); sh[i] = *(const f32x4*)(mod + c); sc[i] = *(const f32x4*)(mod + 1024 + c) + 1.0f; }
        f32x4 v[4];
#pragma unroll
        for (int i = 0; i < 4; ++i) v[i] = ((const f32x4*)(x + (size_t)base * D))[i * 64 + lane];
#pragma unroll 2
        for (int k = 0; k < RPW; ++k) {
            const int row = base + k, rn = (k + 1 < RPW) ? row + 1 : row;
            f32x4 vn[4];
#pragma unroll
            for (int i = 0; i < 4; ++i) vn[i] = ((const f32x4*)(x + (size_t)rn * D))[i * 64 + lane];
            float ss = 0.f;
#pragma unroll
            for (int i = 0; i < 4; ++i) ss += v[i][0] * v[i][0] + v[i][1] * v[i][1] + v[i][2] * v[i][2] + v[i][3] * v[i][3];
            ss = wave_sum(ss);
            const float rs = rsqrtf(ss * (1.0f / D) + 1e-6f);
#pragma unroll
            for (int i = 0; i < 4; ++i) {
                float r[4];
#pragma unroll
                for (int j = 0; j < 4; ++j) r[j] = (v[i][j] * rs * g[i][j]) * sc[i][j] + sh[i][j];
                u32x2 w; w.x = cvt_pk_bf16(r[0], r[1]); w.y = cvt_pk_bf16(r[2], r[3]);
                *(u32x2*)(HB + (size_t)row * D + i * 256 + lane * 4) = w;
            }
#pragma unroll
            for (int i = 0; i < 4; ++i) v[i] = vn[i];
        }
    }
}
__device__ __forceinline__ void p13_mid(const Args& a) {
    const int lane = threadIdx.x & 63, wave = threadIdx.x >> 6;
    const float* x = a.in[0]; const float* gpost = a.in[5]; const float* gpre2 = a.in[6]; const float* MOD = (const float*)(a.ws + WS_MOD);
    const bf16_t* MX = (const bf16_t*)(a.ws + WS_MIXED); bf16_t* HB = (bf16_t*)(a.ws + WS_HB); float* out = a.out;
    for (int base = (blockIdx.x * 8 + wave) * RPW; base < M; base += gridDim.x * 8 * RPW) {
        const float* mod = MOD + (base / T) * 6144;
        f32x4 gg[4], g2[4], sh[4], sc[4];
#pragma unroll
        for (int i = 0; i < 4; ++i) { const int c = i * 256 + lane * 4; gg[i] = *(const f32x4*)(gpost + c) * *(const f32x4*)(mod + 2048 + c); g2[i] = *(const f32x4*)(gpre2 + c);
                                      sh[i] = *(const f32x4*)(mod + 3072 + c); sc[i] = *(const f32x4*)(mod + 4096 + c) + 1.0f; }
        u32x2 m[4]; f32x4 xv[4];
#pragma unroll
        for (int i = 0; i < 4; ++i) { m[i] = *(const u32x2*)(MX + (size_t)base * D + i * 256 + lane * 4); xv[i] = *(const f32x4*)(x + (size_t)base * D + i * 256 + lane * 4); }
#pragma unroll 2
        for (int k = 0; k < RPW; ++k) {
            const int row = base + k, rn = (k + 1 < RPW) ? row + 1 : row;
            u32x2 mn[4]; f32x4 xn[4];
#pragma unroll
            for (int i = 0; i < 4; ++i) { mn[i] = *(const u32x2*)(MX + (size_t)rn * D + i * 256 + lane * 4); xn[i] = *(const f32x4*)(x + (size_t)rn * D + i * 256 + lane * 4); }
            f32x4 v[4]; float ss = 0.f;
#pragma unroll
            for (int i = 0; i < 4; ++i) { v[i] = (f32x4){lo_bf(m[i].x), hi_bf(m[i].x), lo_bf(m[i].y), hi_bf(m[i].y)}; ss += v[i][0] * v[i][0] + v[i][1] * v[i][1] + v[i][2] * v[i][2] + v[i][3] * v[i][3]; }
            ss = wave_sum(ss);
            const float rs = rsqrtf(ss * (1.0f / D) + 1e-6f);
            float ss2 = 0.f;
#pragma unroll
            for (int i = 0; i < 4; ++i) {
#pragma unroll
                for (int j = 0; j < 4; ++j) { v[i][j] = xv[i][j] + gg[i][j] * (v[i][j] * rs); ss2 += v[i][j] * v[i][j]; }
            }
            ss2 = wave_sum(ss2);
            const float rs2 = rsqrtf(ss2 * (1.0f / D) + 1e-6f);
#pragma unroll
            for (int i = 0; i < 4; ++i) {
                float r[4];
#pragma unroll
                for (int j = 0; j < 4; ++j) r[j] = (v[i][j] * rs2 * g2[i][j]) * sc[i][j] + sh[i][j];
                u32x2 w; w.x = cvt_pk_bf16(r[0], r[1]); w.y = cvt_pk_bf16(r[2], r[3]);
                *(u32x2*)(HB + (size_t)row * D + i * 256 + lane * 4) = w;
            }
#pragma unroll
            for (int i = 0; i < 4; ++i) { m[i] = mn[i]; xv[i] = xn[i]; }
        }
    }
}
__device__ __forceinline__ void p16_final(const Args& a) {
    const int lane = threadIdx.x & 63, wave = threadIdx.x >> 6;
    const float* x = a.in[0]; const float* gpm = a.in[5]; const float* gpost = a.in[7]; const float* MOD = (const float*)(a.ws + WS_MOD);
    const bf16_t* MX = (const bf16_t*)(a.ws + WS_MIXED); const bf16_t* Y2 = (const bf16_t*)(a.ws + WS_Y2); float* out = a.out;
    for (int base = (blockIdx.x * 8 + wave) * RPW; base < M; base += gridDim.x * 8 * RPW) {
        const float* mod = MOD + (base / T) * 6144;
        f32x4 gm[4], gg[4];
#pragma unroll
        for (int i = 0; i < 4; ++i) { const int c = i * 256 + lane * 4; gm[i] = *(const f32x4*)(gpm + c) * *(const f32x4*)(mod + 2048 + c); gg[i] = *(const f32x4*)(gpost + c) * *(const f32x4*)(mod + 5120 + c); }
        u32x2 m[4], y[4]; f32x4 xv[4];
#pragma unroll
        for (int i = 0; i < 4; ++i) { const size_t o = (size_t)base * D + i * 256 + lane * 4; m[i] = *(const u32x2*)(MX + o); y[i] = *(const u32x2*)(Y2 + o); xv[i] = *(const f32x4*)(x + o); }
#pragma unroll 2
        for (int k = 0; k < RPW; ++k) {
            const int row = base + k, rn = (k + 1 < RPW) ? row + 1 : row;
            u32x2 mn[4], yn[4]; f32x4 xn[4];
#pragma unroll
            for (int i = 0; i < 4; ++i) { const size_t o = (size_t)rn * D + i * 256 + lane * 4; mn[i] = *(const u32x2*)(MX + o); yn[i] = *(const u32x2*)(Y2 + o); xn[i] = *(const f32x4*)(x + o); }
            f32x4 vm[4], vy[4]; float s1 = 0.f, s2 = 0.f;
#pragma unroll
            for (int i = 0; i < 4; ++i) { vm[i] = (f32x4){lo_bf(m[i].x), hi_bf(m[i].x), lo_bf(m[i].y), hi_bf(m[i].y)}; vy[i] = (f32x4){lo_bf(y[i].x), hi_bf(y[i].x), lo_bf(y[i].y), hi_bf(y[i].y)};
                s1 += vm[i][0] * vm[i][0] + vm[i][1] * vm[i][1] + vm[i][2] * vm[i][2] + vm[i][3] * vm[i][3]; s2 += vy[i][0] * vy[i][0] + vy[i][1] * vy[i][1] + vy[i][2] * vy[i][2] + vy[i][3] * vy[i][3]; }
            s1 = wave_sum(s1); s2 = wave_sum(s2);
            const float r1 = rsqrtf(s1 * (1.0f / D) + 1e-6f), r2 = rsqrtf(s2 * (1.0f / D) + 1e-6f);
#pragma unroll
            for (int i = 0; i < 4; ++i) {
                f32x4 o;
#pragma unroll
                for (int j = 0; j < 4; ++j) { const float x1 = xv[i][j] + gm[i][j] * (vm[i][j] * r1); o[j] = x1 + gg[i][j] * (vy[i][j] * r2); }
                *(f32x4*)(out + (size_t)row * D + i * 256 + lane * 4) = o;
            }
#pragma unroll
            for (int i = 0; i < 4; ++i) { m[i] = mn[i]; y[i] = yn[i]; xv[i] = xn[i]; }
        }
    }
}
__device__ __forceinline__ void p6_loramid(const Args& a) {
    const bf16_t* P = (const bf16_t*)(a.ws + WS_P); bf16_t* A2 = (bf16_t*)(a.ws + WS_A2);
    for (int i = blockIdx.x * NTHR + threadIdx.x; i < M * 192; i += gridDim.x * NTHR) {
        const int tok = i / 192, c = (i % 192) * 2;
        float h0 = 0.f, h1 = 0.f;
        if (c < 288) {
            const unsigned cur = *(const unsigned*)(P + (size_t)tok * 768 + c);
            h0 = lo_bf(cur); h1 = hi_bf(cur);
            if ((tok & (T - 1)) != 0) { const unsigned prv = *(const unsigned*)(P + (size_t)(tok - 1) * 768 + 288 + c); h0 += lo_bf(prv); h1 += hi_bf(prv); }
            if (c < 64) { h0 = 1.0f - 2.0f * __builtin_amdgcn_rcpf(__expf(2.0f * h0) + 1.0f); h1 = 1.0f - 2.0f * __builtin_amdgcn_rcpf(__expf(2.0f * h1) + 1.0f); }
            else if (c >= 128) { h0 = sigmoidf_(h0); h1 = sigmoidf_(h1); }
        }
        *(unsigned*)(A2 + (size_t)tok * 384 + c) = cvt_pk_bf16(h0, h1);
    }
}
__device__ __forceinline__ void p4_combine(const Args& a) {
    const bf16_t* OG = (const bf16_t*)((const unsigned char*)a.out + OUT_OG); const float* LSE = (const float*)((const unsigned char*)a.out + OUT_LSE);
    bf16_t* OATT = (bf16_t*)(a.ws + WS_OATT);
    for (int i = blockIdx.x * NTHR + threadIdx.x; i < M * 64; i += gridDim.x * NTHR) {
        const int tok = i >> 6, seg = i & 63, hh = seg >> 3;
        const float l0 = LSE[(size_t)tok * 8 + hh], l1 = LSE[(size_t)M * 8 + (size_t)tok * 8 + hh], l2 = LSE[(size_t)2 * M * 8 + (size_t)tok * 8 + hh];
        const float mx = fmaxf(l0, fmaxf(l1, l2));
        float w0 = __expf(l0 - mx), w1 = __expf(l1 - mx), w2 = __expf(l2 - mx);
        const float inv = __builtin_amdgcn_rcpf(w0 + w1 + w2); w0 *= inv; w1 *= inv; w2 *= inv;
        const u32x4 o0 = *(const u32x4*)(OG + (size_t)tok * 512 + seg * 8), o1 = *(const u32x4*)(OG + (size_t)M * 512 + (size_t)tok * 512 + seg * 8),
                    o2 = *(const u32x4*)(OG + (size_t)2 * M * 512 + (size_t)tok * 512 + seg * 8);
        u32x4 w;
        w.x = cvt_pk_bf16(w0 * lo_bf(o0.x) + w1 * lo_bf(o1.x) + w2 * lo_bf(o2.x), w0 * hi_bf(o0.x) + w1 * hi_bf(o1.x) + w2 * hi_bf(o2.x));
        w.y = cvt_pk_bf16(w0 * lo_bf(o0.y) + w1 * lo_bf(o1.y) + w2 * lo_bf(o2.y), w0 * hi_bf(o0.y) + w1 * hi_bf(o1.y) + w2 * hi_bf(o2.y));
        w.z = cvt_pk_bf16(w0 * lo_bf(o0.z) + w1 * lo_bf(o1.z) + w2 * lo_bf(o2.z), w0 * hi_bf(o0.z) + w1 * hi_bf(o1.z) + w2 * hi_bf(o2.z));
        w.w = cvt_pk_bf16(w0 * lo_bf(o0.w) + w1 * lo_bf(o1.w) + w2 * lo_bf(o2.w), w0 * hi_bf(o0.w) + w1 * hi_bf(o1.w) + w2 * hi_bf(o2.w));
        *(u32x4*)(OATT + (size_t)tok * 512 + seg * 8) = w;
    }
}

constexpr int QP = 72, VP = 392;
constexpr int ATT_Q = 0, ATT_K = 256 * QP * 2, ATT_V = ATT_K + 384 * QP * 2;
constexpr int ATT_ITEMS = 3072;
struct AttItem { int g, b, hh, r, n, dsh; };
__device__ __forceinline__ AttItem att_decode(int item) {
    AttItem it; it.g = item / 1024; it.b = (item >> 8) & 3; it.hh = (item >> 5) & 7; const int rb = item & 31;
    it.dsh = 2 * it.g; const int nbk = 32 >> it.dsh; it.r = rb / nbk; it.n = 2 * (rb % nbk); return it;
}
__device__ __forceinline__ void att_load(const bf16_t* QKVA, const AttItem& it, int tid, u32x4 (&q)[4], u32x4 (&k)[6], u32x4 (&v)[6]) {
    const size_t SEC = (size_t)3 * 8 * 4 * T * 64;
    const int L = T >> it.dsh;
    const bf16_t* base = QKVA + ((((size_t)(it.g * 8 + it.hh) * 4 + it.b) * T + (size_t)it.r * L) << 6);
#pragma unroll
    for (int i = 0; i < 4; ++i) { const int p = tid + i * NTHR, row = p >> 3, seg = p & 7;
        q[i] = *(const u32x4*)(base + ((size_t)(128 * it.n + row) << 6) + seg * 8); }
#pragma unroll
    for (int i = 0; i < 6; ++i) { const int p = tid + i * NTHR, row = p >> 3, seg = p & 7; const int uu = 128 * (it.n - 1) + row;
        k[i] = (u32x4){0u, 0u, 0u, 0u};
        if (uu >= 0) k[i] = *(const u32x4*)(base + SEC + ((size_t)uu << 6) + seg * 8); }
#pragma unroll
    for (int i = 0; i < 3; ++i) { const int idx = tid + i * NTHR, kp = idx % 192, seg = idx / 192; const int uu = 128 * (it.n - 1) + 2 * kp;
        v[2 * i] = (u32x4){0u, 0u, 0u, 0u}; v[2 * i + 1] = (u32x4){0u, 0u, 0u, 0u};
        if (uu >= 0) { const bf16_t* vp = base + 2 * SEC + ((size_t)uu << 6) + seg * 8;
                       v[2 * i] = *(const u32x4*)vp; v[2 * i + 1] = *(const u32x4*)(vp + 64); } }
}
__device__ __forceinline__ void att_store(LAS bf16_t* Qs, LAS bf16_t* Ks, LAS bf16_t* Vt, int tid, const u32x4 (&q)[4], const u32x4 (&k)[6], const u32x4 (&v)[6]) {
#pragma unroll
    for (int i = 0; i < 4; ++i) { const int p = tid + i * NTHR, row = p >> 3, seg = p & 7; *(LAS u32x4*)(Qs + row * QP + seg * 8) = q[i]; }
#pragma unroll
    for (int i = 0; i < 6; ++i) { const int p = tid + i * NTHR, row = p >> 3, seg = p & 7; *(LAS u32x4*)(Ks + row * QP + seg * 8) = k[i]; }
#pragma unroll
    for (int i = 0; i < 3; ++i) { const int idx = tid + i * NTHR, kp = idx % 192, seg = idx / 192;
        const int k0 = 2 * kp, vpos = (k0 & ~31) + 8 * ((k0 >> 2) & 3) + 4 * ((k0 >> 4) & 1) + (k0 & 3);
        LAS unsigned* vd = (LAS unsigned*)(Vt + (seg * 8) * VP + vpos);
        const u32x4 a = v[2 * i], b2 = v[2 * i + 1];
        vd[0 * (VP / 2)] = (a.x & 0xffffu) | (b2.x << 16); vd[1 * (VP / 2)] = (a.x >> 16) | (b2.x & 0xffff0000u);
        vd[2 * (VP / 2)] = (a.y & 0xffffu) | (b2.y << 16); vd[3 * (VP / 2)] = (a.y >> 16) | (b2.y & 0xffff0000u);
        vd[4 * (VP / 2)] = (a.z & 0xffffu) | (b2.z << 16); vd[5 * (VP / 2)] = (a.z >> 16) | (b2.z & 0xffff0000u);
        vd[6 * (VP / 2)] = (a.w & 0xffffu) | (b2.w << 16); vd[7 * (VP / 2)] = (a.w >> 16) | (b2.w & 0xffff0000u); }
}
template <int P, bool GEN> __device__ __forceinline__ float att_mask(f32x4 (&s)[10], float basef, float dhi, float nslope) {
    float mx = -1e30f;
#pragma unroll
    for (int i = 0; i < 10; ++i)
#pragma unroll
        for (int j = 0; j < 4; ++j) {
            const int e = i - P; const float dl = basef - (float)(16 * i + j);
            if (!GEN && (e < 0 || e > 8)) { s[i][j] = -1e30f; }
            else if (!GEN && e >= 1 && e <= 7) { const float v = __builtin_fmaf(nslope, dl, s[i][j]); s[i][j] = v; mx = fmaxf(mx, v); }
            else { const bool valid = __builtin_fmaxf(__builtin_fminf(dl, dhi), 0.0f) == dl;
                   const float v = valid ? __builtin_fmaf(nslope, dl, s[i][j]) : -1e30f; s[i][j] = v; mx = fmaxf(mx, v); }
        }
    return mx;
}
__device__ __forceinline__ void p3_attention(const Args& a, LAS unsigned char* lds) {
    const int tid = threadIdx.x, lane = tid & 63, w = tid >> 6, l15 = lane & 15, q4 = lane >> 4;
    const bf16_t* QKVA = (const bf16_t*)(a.ws + WS_QKVA);
    bf16_t* OG = (bf16_t*)((unsigned char*)a.out + OUT_OG); float* LSE = (float*)((unsigned char*)a.out + OUT_LSE);
    LAS bf16_t* Qs = (LAS bf16_t*)(lds + ATT_Q); LAS bf16_t* Ks = (LAS bf16_t*)(lds + ATT_K); LAS bf16_t* Vt = (LAS bf16_t*)(lds + ATT_V);
    const int G = gridDim.x, bx = blockIdx.x;
    const int vcu = (G % 8 == 0) ? (bx % 8) * (G / 8) + bx / 8 : bx;
    u32x4 rq[4], rk[6], rv[6];
    int item = vcu;
    if (item < ATT_ITEMS) { const AttItem it = att_decode(item); att_load(QKVA, it, tid, rq, rk, rv); }
    __syncthreads();
    if (item < ATT_ITEMS) att_store(Qs, Ks, Vt, tid, rq, rk, rv);
    __syncthreads();
    for (; item < ATT_ITEMS; item += G) {
        const AttItem it = att_decode(item);
        const int g = it.g, b = it.b, hh = it.hh, r = it.r, dsh = it.dsh, d = 1 << dsh;
        const int nxt = item + G;
        if (nxt < ATT_ITEMS) { const AttItem itn = att_decode(nxt); att_load(QKVA, itn, tid, rq, rk, rv); }
        const int cb = 32 * (w >> 1);
        const int iq = 16 * w + l15;
#pragma unroll 1
        for (int sb = 0; sb < 2; ++sb) {
        const int n = it.n + sb, qo = 128 * sb, cbs = 128 * sb + cb;
        bf16x8 qf[2];
#pragma unroll
        for (int ks = 0; ks < 2; ++ks) qf[ks] = *(const LAS bf16x8*)(Qs + (qo + iq) * QP + ks * 32 + q4 * 8);
        f32x4 s[10];
#pragma unroll
        for (int i = 0; i < 10; ++i) {
            s[i] = (f32x4){0.f, 0.f, 0.f, 0.f};
#pragma unroll
            for (int ks = 0; ks < 2; ++ks) { const bf16x8 kf = *(const LAS bf16x8*)(Ks + (cbs + 16 * i + l15) * QP + ks * 32 + q4 * 8);
                s[i] = __builtin_amdgcn_mfma_f32_16x16x32_bf16(kf, qf[ks], s[i], 0, 0, 0); }
        }
        const int sidx = 8 * g + hh;
        const float nslope = -1.4426950408889634f * exp2f(sidx < 16 ? -0.25f * (float)(sidx + 1) : -4.0f - 0.5f * (float)(sidx - 15)) * (float)d;
        const float basef = (float)(iq - cb - 4 * q4 + 128);
        const float dhi = (n > 0) ? 128.0f : fminf(128.0f, (float)iq);
        float mx = (n == 0) ? att_mask<0, true>(s, basef, dhi, nslope) : ((w & 1) ? att_mask<1, false>(s, basef, dhi, nslope) : att_mask<0, false>(s, basef, dhi, nslope));
        { const int xi = __float_as_int(mx); const auto r16 = __builtin_amdgcn_permlane16_swap(xi, xi, false, false); mx = fmaxf(__int_as_float(r16[0]), __int_as_float(r16[1]));
          const int yi = __float_as_int(mx); const auto r32 = __builtin_amdgcn_permlane32_swap(yi, yi, false, false); mx = fmaxf(__int_as_float(r32[0]), __int_as_float(r32[1])); }
        float den = 0.f;
#pragma unroll
        for (int i = 0; i < 10; ++i)
#pragma unroll
            for (int j = 0; j < 4; ++j) { const float p = __builtin_amdgcn_exp2f(s[i][j] - mx); s[i][j] = p; den += p; }
        { const int xi = __float_as_int(den); const auto r16 = __builtin_amdgcn_permlane16_swap(xi, xi, false, false); den = __int_as_float(r16[0]) + __int_as_float(r16[1]);
          const int yi = __float_as_int(den); const auto r32 = __builtin_amdgcn_permlane32_swap(yi, yi, false, false); den = __int_as_float(r32[0]) + __int_as_float(r32[1]); }
        f32x4 o[4];
#pragma unroll
        for (int dt = 0; dt < 4; ++dt) o[dt] = (f32x4){0.f, 0.f, 0.f, 0.f};
#pragma unroll
        for (int c = 0; c < 5; ++c) {
            u32x4 pw; pw.x = cvt_pk_bf16(s[2 * c][0], s[2 * c][1]); pw.y = cvt_pk_bf16(s[2 * c][2], s[2 * c][3]); pw.z = cvt_pk_bf16(s[2 * c + 1][0], s[2 * c + 1][1]); pw.w = cvt_pk_bf16(s[2 * c + 1][2], s[2 * c + 1][3]);
            const bf16x8 pf = __builtin_bit_cast(bf16x8, pw);
#pragma unroll
            for (int dt = 0; dt < 4; ++dt) {
                const bf16x8 vf = *(const LAS bf16x8*)(Vt + (dt * 16 + l15) * VP + cbs + 32 * c + 8 * q4);
                o[dt] = __builtin_amdgcn_mfma_f32_16x16x32_bf16(vf, pf, o[dt], 0, 0, 0);
            }
        }
        const float inv = __builtin_amdgcn_rcpf(den);
        const size_t tok = (size_t)b * T + (((128 * n + iq) << dsh) + r);
        bf16_t* op = OG + (size_t)g * M * 512 + tok * 512 + hh * 64 + q4 * 4;
#pragma unroll
        for (int dt = 0; dt < 4; ++dt) { u32x2 ww; ww.x = cvt_pk_bf16(o[dt][0] * inv, o[dt][1] * inv); ww.y = cvt_pk_bf16(o[dt][2] * inv, o[dt][3] * inv); *(u32x2*)(op + dt * 16) = ww; }
        if (q4 == 0) LSE[(size_t)g * M * 8 + tok * 8 + hh] = (mx + __builtin_amdgcn_logf(den)) * 0.6931471805599453f;
        }
        __syncthreads();
        if (nxt < ATT_ITEMS) att_store(Qs, Ks, Vt, tid, rq, rk, rv);
        __syncthreads();
    }
}

constexpr int TC = 32, SPITCH = 392;
typedef float f32x2 __attribute__((ext_vector_type(2)));
template <int CTRL> __device__ __forceinline__ float dpp_f(float x) { return __int_as_float(__builtin_amdgcn_update_dpp(0, __float_as_int(x), CTRL, 0xf, 0xf, false)); }
struct ScanRegs { u32x2 pr, pk, pv, qr, qk, qv, wl, as; };
__device__ __forceinline__ void scan_issue(ScanRegs& R, const bf16_t* PRKV, const unsigned short* WLOG, const bf16_t* ASIG, size_t tok, int ch, int want_prev) {
    const bf16_t* pp = PRKV + tok * 3072 + ch;
    R.pr = *(const u32x2*)pp; R.pk = *(const u32x2*)(pp + 1024); R.pv = *(const u32x2*)(pp + 2048);
    R.qr = (u32x2){0u, 0u}; R.qk = (u32x2){0u, 0u}; R.qv = (u32x2){0u, 0u};
    if (want_prev == 1) { R.qr = *(const u32x2*)(pp - 3072); R.qk = *(const u32x2*)(pp - 3072 + 1024); R.qv = *(const u32x2*)(pp - 3072 + 2048); }
    R.wl = *(const u32x2*)(WLOG + tok * 1024 + ch); R.as = *(const u32x2*)(ASIG + tok * 1024 + ch);
}
__device__ __forceinline__ void unpack4(const u32x2 u, float (&f)[4]) { f[0] = lo_bf(u.x); f[1] = hi_bf(u.x); f[2] = lo_bf(u.y); f[3] = hi_bf(u.y); }
__device__ __forceinline__ float scan_prepare(const ScanRegs& R, const u32x2 qr_, const u32x2 qk_, const u32x2 qv_, LAS float* slot, int cq, const f32x4 mur, const f32x4 muk, const f32x4 muv, const f32x4 kkc, const f32x4 kac, const f32x4 rkc) {
    float pr[4], pk[4], pv[4], qr[4], qk[4], qv[4], av[4], om[4];
    unpack4(R.pr, pr); unpack4(R.pk, pk); unpack4(R.pv, pv); unpack4(qr_, qr); unpack4(qk_, qk); unpack4(qv_, qv); unpack4(R.as, av);
    om[0] = f16_to_f((unsigned short)(R.wl.x & 0xffffu)); om[1] = f16_to_f((unsigned short)(R.wl.x >> 16)); om[2] = f16_to_f((unsigned short)(R.wl.y & 0xffffu)); om[3] = f16_to_f((unsigned short)(R.wl.y >> 16));
    float rr[4], vv[4], kn[4], k2[4], dec[4], bu[4];
    float ssq = 0.f, bon = 0.f, c1 = 0.f, c2 = 0.f;
#pragma unroll
    for (int j = 0; j < 4; ++j) {
        rr[j] = pr[j] + (qr[j] - pr[j]) * mur[j]; const float kk0 = pk[j] + (qk[j] - pk[j]) * muk[j]; vv[j] = pv[j] + (qv[j] - pv[j]) * muv[j];
        dec[j] = 1.0f - om[j];
        kn[j] = kk0 * kkc[j]; ssq += kn[j] * kn[j];
        k2[j] = kk0 * (1.0f + (av[j] - 1.0f) * kac[j]);
        const float t = rr[j] * k2[j]; bon += t * rkc[j]; c2 += t;
        bu[j] = kn[j] * av[j]; c1 += bu[j] * rr[j];
    }
    ssq += dpp_f<0x121>(ssq); bon += dpp_f<0x121>(bon); c1 += dpp_f<0x121>(c1); c2 += dpp_f<0x121>(c2);
    ssq += dpp_f<0x122>(ssq); bon += dpp_f<0x122>(bon); c1 += dpp_f<0x122>(c1); c2 += dpp_f<0x122>(c2);
    ssq += dpp_f<0x124>(ssq); bon += dpp_f<0x124>(bon); c1 += dpp_f<0x124>(c1); c2 += dpp_f<0x124>(c2);
    ssq += dpp_f<0x128>(ssq); bon += dpp_f<0x128>(bon); c1 += dpp_f<0x128>(c1); c2 += dpp_f<0x128>(c2);
    const float inv = __builtin_amdgcn_rsqf(fmaxf(ssq, 1e-24f));
    f32x4 o_al, o_be, o_wr;
#pragma unroll
    for (int j = 0; j < 4; ++j) { o_al[j] = -(kn[j] * inv); o_be[j] = bu[j] * inv; o_wr[j] = dec[j] * rr[j]; }
    LAS f32x4* s4 = (LAS f32x4*)slot;
    s4[cq] = (f32x4){dec[0], dec[1], dec[2], dec[3]}; s4[16 + cq] = (f32x4){k2[0], k2[1], k2[2], k2[3]}; s4[32 + cq] = o_al; s4[48 + cq] = o_be; s4[64 + cq] = o_wr;
    s4[80 + cq] = (f32x4){vv[0], vv[1], vv[2], vv[3]};
    if (cq == 0) *(LAS f32x2*)(slot + 384) = (f32x2){c1 * inv, c2};
    return bon;
}
__device__ __forceinline__ float ysum4(const LAS float* p) { const f32x4 a = *(const LAS f32x4*)p; return (a[0] + a[1]) + (a[2] + a[3]); }
struct ScanOps { f32x4 wv, kv, al, be, wr; f32x2 cc; float vi; };
__device__ __forceinline__ void scan_ld(ScanOps& o, const LAS float* sl, int jq4, int myrow) {
    o.al = *(const LAS f32x4*)(sl + 128 + jq4); o.wr = *(const LAS f32x4*)(sl + 256 + jq4); o.vi = sl[320 + myrow]; o.kv = *(const LAS f32x4*)(sl + 64 + jq4);
    o.be = *(const LAS f32x4*)(sl + 192 + jq4); o.wv = *(const LAS f32x4*)(sl + jq4); o.cc = *(const LAS f32x2*)(sl + 384);
}
__device__ __forceinline__ void p8_scan(const Args& a, LAS unsigned char* lds) {
    const int tid = threadIdx.x, lane = tid & 63, w = __builtin_amdgcn_readfirstlane(tid >> 6);
    const bf16_t* PRKV = (const bf16_t*)(a.ws + WS_PRKV); const unsigned short* WLOG = (const unsigned short*)(a.ws + WS_WLOG);
    const bf16_t* ASIG = (const bf16_t*)((const unsigned char*)a.out + OUT_ASIG);
    bf16_t* Y = (bf16_t*)(a.ws + WS_Y); float* BONUS = (float*)(a.ws + WS_BONUS);
    const float* mu_rkv = a.in[9]; const float* k_k = a.in[19]; const float* k_a = a.in[20]; const float* r_k = a.in[21];
    LAS float* buf = (LAS float*)lds;
    LAS float* ybuf = (LAS float*)(lds + 2 * TC * SPITCH * 4);
    LAS float* dump = ybuf + 2 * TC * 64;
    const int p = tid & 255, ltt = p >> 4, cq = p & 15;
    const int jq4 = 4 * (lane & 15);
    for (int item = blockIdx.x; item < 256; item += gridDim.x) {
        const int bh = item & 63, rq = item >> 6, b = bh >> 4, h = bh & 15;
        const int ch = h * 64 + 4 * cq;
        const int myrow = 16 * rq + 4 * (w & 3) + (lane >> 4);
        __syncthreads();
        if (w >= 4) {
            const f32x4 mur = *(const f32x4*)(mu_rkv + ch), muk = *(const f32x4*)(mu_rkv + 1024 + ch), muv = *(const f32x4*)(mu_rkv + 2048 + ch),
                        kkc = *(const f32x4*)(k_k + ch), kac = *(const f32x4*)(k_a + ch), rkc = *(const f32x4*)(r_k + ch);
            ScanRegs A0, A1, B0, B1;
            { const size_t tok = (size_t)b * T + 2 * ltt; scan_issue(A0, PRKV, WLOG, ASIG, tok, ch, ltt > 0 ? 1 : 2); scan_issue(A1, PRKV, WLOG, ASIG, tok + 1, ch, 0);
              const float b0 = scan_prepare(A0, A0.qr, A0.qk, A0.qv, buf + (2 * ltt) * SPITCH, cq, mur, muk, muv, kkc, kac, rkc);
              const float b1 = scan_prepare(A1, A0.pr, A0.pk, A0.pv, buf + (2 * ltt + 1) * SPITCH, cq, mur, muk, muv, kkc, kac, rkc);
              if (rq == 0 && cq == 0) { BONUS[tok * 16 + h] = b0; BONUS[(tok + 1) * 16 + h] = b1; }
              scan_issue(A0, PRKV, WLOG, ASIG, tok + TC, ch, 1); scan_issue(A1, PRKV, WLOG, ASIG, tok + TC + 1, ch, 0);
              scan_issue(B0, PRKV, WLOG, ASIG, tok + 2 * TC, ch, 1); scan_issue(B1, PRKV, WLOG, ASIG, tok + 2 * TC + 1, ch, 0); }
            __syncthreads();
#define PROD_STEP(c, X0, X1) do { \
                const int cur = (c) & 1; \
                const size_t tokn = (size_t)b * T + ((c) + 1) * TC + 2 * ltt; \
                if ((c) > 0) { const LAS float* yb = ybuf + (cur ^ 1) * TC * 64; bf16_t* yd = Y + ((size_t)b * T + ((c) - 1) * TC + 2 * ltt) * 1024 + h * 64 + 16 * rq + cq; \
                               yd[0] = f2bf(ysum4(yb + (2 * ltt) * 64 + cq * 4)); yd[1024] = f2bf(ysum4(yb + (2 * ltt + 1) * 64 + cq * 4)); } \
                if ((c) + 1 < T / TC) { \
                    LAS float* nb = buf + (cur ^ 1) * TC * SPITCH; \
                    const float b0 = scan_prepare(X0, X0.qr, X0.qk, X0.qv, nb + (2 * ltt) * SPITCH, cq, mur, muk, muv, kkc, kac, rkc); \
                    const float b1 = scan_prepare(X1, X0.pr, X0.pk, X0.pv, nb + (2 * ltt + 1) * SPITCH, cq, mur, muk, muv, kkc, kac, rkc); \
                    if (rq == 0 && cq == 0) { BONUS[tokn * 16 + h] = b0; BONUS[(tokn + 1) * 16 + h] = b1; } \
                    if ((c) + 3 < T / TC) { scan_issue(X0, PRKV, WLOG, ASIG, tokn + 2 * TC, ch, 1); scan_issue(X1, PRKV, WLOG, ASIG, tokn + 2 * TC + 1, ch, 0); } \
                } \
                __syncthreads(); } while (0)
            for (int c = 0; c < T / TC; c += 2) { PROD_STEP(c, A0, A1); PROD_STEP(c + 1, B0, B1); }
#undef PROD_STEP
            { const LAS float* yb = ybuf + 1 * TC * 64; bf16_t* yd = Y + ((size_t)b * T + (T / TC - 1) * TC + 2 * ltt) * 1024 + h * 64 + 16 * rq + cq;
              yd[0] = f2bf(ysum4(yb + (2 * ltt) * 64 + cq * 4)); yd[1024] = f2bf(ysum4(yb + (2 * ltt + 1) * 64 + cq * 4)); }
        } else {
            f32x2 S01 = (f32x2){0.f, 0.f}, S23 = (f32x2){0.f, 0.f};
            const bool holds_y = (lane & 3) == 0;
            const float m0 = (lane & 15) == 0 ? 1.0f : 0.0f;
            __syncthreads();
            for (int c = 0; c < T / TC; ++c) {
                const int cur = c & 1;
                const LAS float* bt = buf + cur * TC * SPITCH;
                LAS float* yd = holds_y ? (ybuf + cur * TC * 64 + 4 * (4 * w + (lane >> 4)) + ((lane & 15) >> 2)) : (dump + lane);
                ScanOps o; scan_ld(o, bt, jq4, myrow);
#pragma unroll 8
                for (int tt = 0; tt < TC; ++tt) {
                    ScanOps n; scan_ld(n, bt + (tt + 1 < TC ? tt + 1 : tt) * SPITCH, jq4, myrow);
                    __builtin_amdgcn_sched_barrier(0);
                    f32x2 ta = S01 * o.al.lo, ty = S01 * o.wr.lo; ta = S23 * o.al.hi + ta; ty = S23 * o.wr.hi + ty;
                    float pa = ta.x + ta.y, py = ty.x + ty.y;
                    f32x2 kv01 = o.kv.lo * o.vi, kv23 = o.kv.hi * o.vi;
                    float vc = o.vi * o.cc.y;
                    asm volatile("" : "+v"(kv01), "+v"(kv23), "+v"(vc));
                    pa += dpp_f<0x121>(pa); py += dpp_f<0x121>(py); pa += dpp_f<0x122>(pa); py += dpp_f<0x122>(py);
                    pa += dpp_f<0x124>(pa); pa += dpp_f<0x128>(pa);
                    S01 = S01 * o.wv.lo + (o.be.lo * pa + kv01);
                    S23 = S23 * o.wv.hi + (o.be.hi * pa + kv23);
                    yd[tt * 64] = (pa * o.cc.x + vc) * m0 + py;
                    __builtin_amdgcn_sched_barrier(0);
                    o = n;
                }
                __syncthreads();
            }
        }
    }
}
struct P8bRow { u32x4 y0, y1, v0, v1, g0, g1; float bon; };
__device__ __forceinline__ void p8b_load(P8bRow& r, const bf16_t* Y, const bf16_t* PRKV, const bf16_t* GG, const float* BONUS, int row, int c0, int lane) {
    r.y0 = *(const u32x4*)(Y + (size_t)row * 1024 + c0); r.y1 = *(const u32x4*)(Y + (size_t)row * 1024 + c0 + 8);
    r.v0 = *(const u32x4*)(PRKV + (size_t)row * 3072 + 2048 + c0); r.v1 = *(const u32x4*)(PRKV + (size_t)row * 3072 + 2048 + c0 + 8);
    r.g0 = *(const u32x4*)(GG + (size_t)row * 1024 + c0); r.g1 = *(const u32x4*)(GG + (size_t)row * 1024 + c0 + 8);
    r.bon = BONUS[(size_t)row * 16 + (lane >> 2)];
}
__device__ __forceinline__ void unpack8(const u32x4 u, float (&f)[8]) { f[0] = lo_bf(u.x); f[1] = hi_bf(u.x); f[2] = lo_bf(u.y); f[3] = hi_bf(u.y); f[4] = lo_bf(u.z); f[5] = hi_bf(u.z); f[6] = lo_bf(u.w); f[7] = hi_bf(u.w); }
__device__ __forceinline__ void p8b_post(const Args& a) {
    const int lane = threadIdx.x & 63, wave = threadIdx.x >> 6;
    const bf16_t* PRKV = (const bf16_t*)(a.ws + WS_PRKV); bf16_t* Y = (bf16_t*)(a.ws + WS_Y); const float* BONUS = (const float*)(a.ws + WS_BONUS);
    const bf16_t* GG = (const bf16_t*)((const unsigned char*)a.out + OUT_GG);
    const float* muv = a.in[9] + 2048; const float* lnw = a.in[22]; const float* lnb = a.in[23];
    const int c0 = lane * 16;
    f32x4 mu[4], lw[4], lb[4];
#pragma unroll
    for (int i = 0; i < 4; ++i) { mu[i] = *(const f32x4*)(muv + c0 + 4 * i); lw[i] = *(const f32x4*)(lnw + c0 + 4 * i); lb[i] = *(const f32x4*)(lnb + c0 + 4 * i); }
    for (int base = (blockIdx.x * 8 + wave) * RPW; base < M; base += gridDim.x * 8 * RPW) {
        u32x4 p0 = (u32x4){0u, 0u, 0u, 0u}, p1 = (u32x4){0u, 0u, 0u, 0u};
        if ((base & (T - 1)) != 0) { p0 = *(const u32x4*)(PRKV + (size_t)(base - 1) * 3072 + 2048 + c0); p1 = *(const u32x4*)(PRKV + (size_t)(base - 1) * 3072 + 2048 + c0 + 8); }
        P8bRow r; p8b_load(r, Y, PRKV, GG, BONUS, base, c0, lane);
#pragma unroll 2
        for (int k = 0; k < RPW; ++k) {
            const int row = base + k, rn = (k + 1 < RPW) ? row + 1 : row;
            P8bRow n; p8b_load(n, Y, PRKV, GG, BONUS, rn, c0, lane);
            float y[16];
            { float t0[8], t1[8]; unpack8(r.y0, t0); unpack8(r.y1, t1);
#pragma unroll
              for (int j = 0; j < 8; ++j) { y[j] = t0[j]; y[8 + j] = t1[j]; } }
            float s = 0.f;
#pragma unroll
            for (int j = 0; j < 16; ++j) s += y[j];
            s += __shfl_xor(s, 1); s += __shfl_xor(s, 2);
            const float mean = s * (1.0f / 64.0f);
            float q = 0.f;
#pragma unroll
            for (int j = 0; j < 16; ++j) { y[j] -= mean; q += y[j] * y[j]; }
            q += __shfl_xor(q, 1); q += __shfl_xor(q, 2);
            const float rstd = rsqrtf(q * (1.0f / 64.0f) + 64e-5f);
#pragma unroll
            for (int hf = 0; hf < 2; ++hf) {
                float cur[8], prv[8], gv[8];
                unpack8(hf ? r.v1 : r.v0, cur); unpack8(hf ? p1 : p0, prv); unpack8(hf ? r.g1 : r.g0, gv);
                float o[8];
#pragma unroll
                for (int j = 0; j < 8; ++j) { const int jj = hf * 8 + j; const float v = cur[j] + (prv[j] - cur[j]) * mu[jj >> 2][jj & 3];
                                              o[j] = ((y[jj] * rstd) * lw[jj >> 2][jj & 3] + lb[jj >> 2][jj & 3] + r.bon * v) * gv[j]; }
                u32x4 wv; wv.x = cvt_pk_bf16(o[0], o[1]); wv.y = cvt_pk_bf16(o[2], o[3]); wv.z = cvt_pk_bf16(o[4], o[5]); wv.w = cvt_pk_bf16(o[6], o[7]);
                *(u32x4*)(Y + (size_t)row * 1024 + c0 + hf * 8) = wv;
            }
            p0 = r.v0; p1 = r.v1; r = n;
        }
    }
}

__global__ void __launch_bounds__(NTHR, 2) mega(Args a) {
    extern __shared__ __attribute__((aligned(16))) unsigned char lds_raw[];
    LAS unsigned char* lds = (LAS unsigned char*)lds_raw;
    cg::grid_group grid = cg::this_grid();
    unsigned char* ws = a.ws;
    volatile LAS unsigned* bst = (volatile LAS unsigned*)(lds + LDS_BYTES - 16);
    if (threadIdx.x == 0) { bst[0] = 0u; bst[1] = 0u; }
    __syncthreads();
    XcdBarrier bar = xcd_barrier_post((unsigned*)(ws + WS_BAR), bst);
    const int lo = a.ph_lo, hi = a.ph_hi;
#ifndef PHMASK
#define PHMASK 0x3ffff
#endif
#define IN(k) (((PHMASK >> (k)) & 1) && lo <= (k) && (k) < hi)
#define SYNC(k) do { if ((k) + 1 < hi) { if (lo < 0) grid.sync(); else xcd_barrier(bar); } } while (0)
    if (IN(0)) { p0_prologue(a, lds); SYNC(0); }
    if (IN(1)) { p1_prenorm(a); SYNC(1); }
    if (IN(2)) { Epi<EP_QKV> E{(bf16_t*)(ws + WS_QKVA), 4608, nullptr, nullptr, nullptr, nullptr, nullptr, nullptr};
                 run_gemm<EP_QKV>(lds, (const bf16_t*)(ws + WS_HB), (const bf16_t*)(ws + WS_WA), 4608, 1024, E); SYNC(2); }
    if (IN(3)) { p3_attention(a, lds); SYNC(3); }
    if (IN(4)) { p4_combine(a); }
    if (IN(5)) { Epi<EP_SPLIT> E{(bf16_t*)(ws + WS_PRKV), 3072, (bf16_t*)(ws + WS_P), nullptr, nullptr, nullptr, nullptr, nullptr};
                 run_gemm<EP_SPLIT>(lds, (const bf16_t*)(ws + WS_HB), (const bf16_t*)(ws + WS_WB), 3840, 1024, E); SYNC(5); }
    if (IN(6)) { p6_loramid(a); SYNC(6); }
    if (IN(7)) { Epi<EP_L2> E{(bf16_t*)(ws + WS_WLOG), 1024, (bf16_t*)((unsigned char*)a.out + OUT_ASIG), (bf16_t*)((unsigned char*)a.out + OUT_GG), nullptr, nullptr, a.in[11], a.in[14]};
                 run_gemm<EP_L2>(lds, (const bf16_t*)(ws + WS_A2), (const bf16_t*)(ws + WS_W2), 3072, 384, E); SYNC(7); }
    if (IN(8)) { p8_scan(a, lds); SYNC(8); }
    if (IN(9)) { p8b_post(a); }
    if (IN(10)) { Epi<EP_SIG> E{(bf16_t*)((unsigned char*)a.out + OUT_ASIG), 1024, (bf16_t*)(ws + WS_WLOG), nullptr, nullptr, nullptr, nullptr, nullptr};
                  run_gemm<EP_SIG>(lds, (const bf16_t*)(ws + WS_HB), (const bf16_t*)(ws + WS_WC), 2048, 1024, E); SYNC(10); }
    if (IN(11)) { Epi<EP_MULG> E{(bf16_t*)(ws + WS_T1), 1024, nullptr, nullptr, (const bf16_t*)((const unsigned char*)a.out + OUT_ASIG), nullptr, nullptr, nullptr};
                  run_gemm<EP_MULG>(lds, (const bf16_t*)(ws + WS_Y), (const bf16_t*)(ws + WS_WOR), 1024, 1024, E); }
    if (IN(12)) { Epi<EP_MIX> E{(bf16_t*)(ws + WS_MIXIN), 1024, nullptr, nullptr, (const bf16_t*)(ws + WS_WLOG), (const bf16_t*)(ws + WS_T1), nullptr, nullptr};
                  run_gemm<EP_MIX>(lds, (const bf16_t*)(ws + WS_OATT), (const bf16_t*)(ws + WS_WOA), 1024, 512, E); SYNC(12); }
    if (IN(13)) { Epi<EP_PLAIN> E{(bf16_t*)(ws + WS_MIXED), 1024, nullptr, nullptr, nullptr, nullptr, nullptr, nullptr};
                  run_gemm<EP_PLAIN>(lds, (const bf16_t*)(ws + WS_MIXIN), (const bf16_t*)(ws + WS_WOUT), 1024, 1024, E); SYNC(13); }
    if (IN(14)) { p13_mid(a); SYNC(14); }
    if (IN(15)) { Epi<EP_SWIGLU> E{(bf16_t*)(ws + WS_U), 2816, nullptr, nullptr, nullptr, nullptr, nullptr, nullptr};
                  run_gemm<EP_SWIGLU>(lds, (const bf16_t*)(ws + WS_HB), (const bf16_t*)(ws + WS_WFI), 5632, 1024, E); SYNC(15); }
    if (IN(16)) { Epi<EP_PLAIN> E{(bf16_t*)(ws + WS_Y2), 1024, nullptr, nullptr, nullptr, nullptr, nullptr, nullptr};
                  run_gemm<EP_PLAIN>(lds, (const bf16_t*)(ws + WS_U), (const bf16_t*)(ws + WS_WFO), 1024, 2816, E); SYNC(16); }
    if (IN(17)) { p16_final(a); }
#undef IN
#undef SYNC
}

#ifndef MK_MULTI
#define MK_MULTI 0
#endif
extern "C" void kernel_launch(void* const* d_in, const int* in_sizes, int n_in, void* d_out, int out_size, void* d_ws, size_t ws_size, hipStream_t stream) {
    static int grid = 0;
    if (grid == 0) {
        if (n_in != 29 || out_size != M * D || ws_size < WS_END) { fprintf(stderr, "kernel_launch: unexpected problem shape (n_in %d out %d ws %zu)\n", n_in, out_size, ws_size); grid = -1; return; }
        int dev = 0, cus = 0, per_cu = 0;
        hipGetDevice(&dev);
        hipDeviceGetAttribute(&cus, hipDeviceAttributeMultiprocessorCount, dev);
        hipFuncSetAttribute((const void*)mega, hipFuncAttributeMaxDynamicSharedMemorySize, LDS_BYTES);
        hipOccupancyMaxActiveBlocksPerMultiprocessor(&per_cu, (const void*)mega, NTHR, LDS_BYTES);
        if (per_cu < 1) per_cu = 1;
        grid = cus * per_cu;
        (void)hipGetLastError();
    }
    if (grid < 0) return;
    Args a{};
    for (int i = 0; i < 29; ++i) a.in[i] = (const float*)d_in[i];
    a.out = (float*)d_out; a.ws = (unsigned char*)d_ws;
#if MK_MULTI
    for (int ph = 0; ph < NPHASE; ++ph) { a.ph_lo = ph; a.ph_hi = ph + 1; hipLaunchKernelGGL(mega, dim3(grid), dim3(NTHR), LDS_BYTES, stream, a); }
#else
    a.ph_lo = 0; a.ph_hi = NPHASE;
    if (hipMemsetAsync((unsigned char*)d_ws + WS_BAR, 0, XCD_BAR_WORDS * 4, stream) != hipSuccess) { fprintf(stderr, "kernel_launch: memset of the barrier words failed\n"); return; }
    void* args[] = {&a};
    hipError_t e = hipLaunchCooperativeKernel((const void*)mega, dim3(grid), dim3(NTHR), args, LDS_BYTES, stream);
    if (e != hipSuccess) fprintf(stderr, "cooperative launch failed: %s (grid %d)\n", hipGetErrorString(e), grid);
#endif
}
```

```cpp
#include <hip/hip_runtime.h>
#include <hip/hip_cooperative_groups.h>
#include <cstdio>
#include <cstdint>
namespace cg = cooperative_groups;
namespace pg8 {
#define PG8_LAS __attribute__((address_space(3)))
typedef unsigned short bf16_t;
typedef short bf16x8 __attribute__((ext_vector_type(8)));
typedef float f32x4 __attribute__((ext_vector_type(4)));
typedef unsigned u32x4 __attribute__((ext_vector_type(4)));
constexpr int BM = 256, BK = 64, HALF = 128, HTB = HALF * BK * 2  , STAGE_BYTES = 8 * HTB, NXCD = 8, WGM = 8;

__host__ __device__ __forceinline__ int lds_byte(int r, int c) { const int st = (r >> 4) * 2 + (c >> 5), rr = r & 15, cc = c & 31, ob = rr * 64 + cc * 2; return st * 1024 + (ob ^ (((ob >> 9) & 1) << 5)); }
__host__ __device__ __forceinline__ void stage_rc(int b, int& R, int& C) { const int st = b / 1024, sb = b % 1024, swz = sb ^ (((sb >> 9) & 1) << 5); R = (st >> 1) * 16 + swz / 64; C = (st & 1) * 32 + (swz % 64) / 2; }
__host__ __device__ __forceinline__ int perm32(int rho) { const int n = rho >> 4, i = rho & 15; return 8 * (i >> 2) + 4 * n + (i & 3); }

struct Unit { int pm, pn; };
struct Gemm { const bf16_t* A; const bf16_t* Bt; int M, N, K; };

struct StaticOrder {
    int nM, nN, nwg, G, c;
    __host__ __device__ void init(int M, int N, int G_, int c_) { nM = M / BM; nN = N / BM; nwg = nM * nN; G = G_; c = c_; }
    __host__ __device__ bool next(int i, Unit& u) const {
        const long L = (long)i * G + c; if (L >= nwg) return false;
        int wgid = (int)L; { const int q = nwg / NXCD, r = nwg % NXCD, xcd = wgid % NXCD, off = wgid / NXCD; wgid = (xcd < r ? xcd * (q + 1) : r * (q + 1) + (xcd - r) * q) + off; }
        const int nig = WGM * nN, gid = wgid / nig, fm = gid * WGM, gsz = (nM - fm) < WGM ? (nM - fm) : WGM;
        u.pm = fm + ((wgid % nig) % gsz); u.pn = (wgid % nig) / gsz; return true;
    }
    __device__ __forceinline__ void a_ready(const Unit&) const {}
    __device__ __forceinline__ void done(const Unit&) const {}
};
__device__ __forceinline__ unsigned cvt_pk_bf16(float lo, float hi) { unsigned r; asm volatile("v_cvt_pk_bf16_f32 %0, %1, %2" : "=v"(r) : "v"(lo), "v"(hi)); return r; }
template <class Epi, class Sched, bool ALIGN_EPI = false, bool SP2 = false>
__device__ __forceinline__ void gemm_phase(PG8_LAS unsigned char* lds, const Gemm g, const Sched& S, const Epi& E) {
    const int tid = threadIdx.x, wid = __builtin_amdgcn_readfirstlane(tid >> 6), lane = tid & 63, wr = wid >> 2, wc = wid & 3, fr = lane & 15, fq = lane >> 4;
    const int K = g.K, nt = K / BK;
    unsigned voffA[2], voffB[2];
#pragma unroll
    for (int i = 0; i < 2; ++i) { int R, C; stage_rc(tid * 16 + i * 8192, R, C); const int Rb = Epi::PERM ? ((R & ~31) + perm32(R & 31)) : R;
        voffA[i] = (unsigned)(R * K + C) * 2u; voffB[i] = (unsigned)(Rb * K + C) * 2u; }
    const size_t kstep = (size_t)(BK * 2);
    const size_t hstep = (size_t)HALF * K * 2;
    const size_t tstep = 2 * hstep;
    const unsigned ldsw = (unsigned)wid * 1024u;
    const int aoff = lds_byte(wr * 64 + fr, fq * 8), boff = lds_byte(wc * 32 + fr, fq * 8);
#define PG8_SA(b, h) (((b) * 2 + (h)) * HTB)
#define PG8_SB(b, h) ((4 + (b) * 2 + (h)) * HTB)
#define PG8_STAGE(bufoff, gbase, voff) do { _Pragma("unroll") for (int _i = 0; _i < 2; ++_i) \
        __builtin_amdgcn_global_load_lds((const unsigned*)((const char*)(gbase) + (voff)[_i]), (PG8_LAS unsigned*)(lds + (bufoff) + ldsw + _i * 8192), 16, 0, 0); } while (0)
#define PG8_LDA(dst, b, h) do { _Pragma("unroll") for (int m = 0; m < 4; ++m) _Pragma("unroll") for (int k = 0; k < 2; ++k) dst[m][k] = *(const PG8_LAS bf16x8*)(lds + PG8_SA(b, h) + aoff + m * 2048 + k * 1024); } while (0)
#define PG8_LDB(dst, b, h) do { _Pragma("unroll") for (int n = 0; n < 2; ++n) _Pragma("unroll") for (int k = 0; k < 2; ++k) dst[n][k] = *(const PG8_LAS bf16x8*)(lds + PG8_SB(b, h) + boff + n * 2048 + k * 1024); } while (0)
#define PG8_MMA(ai, bj, At, Bt) do { __builtin_amdgcn_s_setprio(1); _Pragma("unroll") for (int m = 0; m < 4; ++m) _Pragma("unroll") for (int n = 0; n < 2; ++n) _Pragma("unroll") for (int k = 0; k < 2; ++k) \
        acc[ai][bj][m][n] = __builtin_amdgcn_mfma_f32_16x16x32_bf16(Bt[n][k], At[m][k], acc[ai][bj][m][n], 0, 0, 0); __builtin_amdgcn_s_setprio(0); } while (0)
#define PG8_WAIT_V(n) asm volatile("s_waitcnt vmcnt(" #n ")" ::: "memory")
#define PG8_WAIT_L(n) asm volatile("s_waitcnt lgkmcnt(" #n ")" ::: "memory")
#define PG8_BAR __builtin_amdgcn_s_barrier()
#define PG8_SCHED __builtin_amdgcn_sched_barrier(0)
    Unit cur, nxt; int ui = 0;
    if (!S.next(0, cur)) return;
    f32x4 acc[2][2][4][2];
#pragma unroll
    for (int a = 0; a < 2; ++a)
#pragma unroll
        for (int b = 0; b < 2; ++b)
#pragma unroll
            for (int m = 0; m < 4; ++m)
#pragma unroll
                for (int n = 0; n < 2; ++n) acc[a][b][m][n] = (f32x4){0.f, 0.f, 0.f, 0.f};
    bf16x8 At[4][2], B0[2][2], B1[2][2];
    const char* cA = (const char*)g.A + (size_t)cur.pm * tstep; const char* cB = (const char*)g.Bt + (size_t)cur.pn * tstep;
    S.a_ready(cur);
    if constexpr (SP2) {
        PG8_STAGE(PG8_SB(0, 0), cB, voffB); PG8_STAGE(PG8_SB(0, 1), cB + hstep, voffB); PG8_STAGE(PG8_SA(0, 0), cA, voffA); PG8_STAGE(PG8_SA(0, 1), cA + hstep, voffA);
        if (wr == 1) PG8_BAR;
        PG8_WAIT_V(2); PG8_BAR;
        PG8_STAGE(PG8_SB(1, 0), cB + kstep, voffB); PG8_STAGE(PG8_SA(1, 0), cA + kstep, voffA); PG8_STAGE(PG8_SB(1, 1), cB + hstep + kstep, voffB);
        PG8_WAIT_V(6); PG8_BAR;
    } else {
        PG8_STAGE(PG8_SB(0, 0), cB, voffB); PG8_STAGE(PG8_SA(0, 0), cA, voffA); PG8_STAGE(PG8_SB(0, 1), cB + hstep, voffB); PG8_STAGE(PG8_SA(0, 1), cA + hstep, voffA);
        if (wr == 1) PG8_BAR;
        PG8_WAIT_V(4); PG8_BAR;
        PG8_STAGE(PG8_SB(1, 0), cB + kstep, voffB); PG8_STAGE(PG8_SA(1, 0), cA + kstep, voffA); PG8_STAGE(PG8_SB(1, 1), cB + hstep + kstep, voffB);
        PG8_WAIT_V(6); PG8_BAR;
    }
    for (;;) {
        const bool has_next = S.next(ui + 1, nxt);
        const char* nA = has_next ? (const char*)g.A + (size_t)nxt.pm * tstep : cA; const char* nB = has_next ? (const char*)g.Bt + (size_t)nxt.pn * tstep : cB;
#pragma nounroll
        for (int t = 0; t < nt; t += 2) {
            const bool last = (t == nt - 2);
            const char* a1 = cA + (size_t)(t + 1) * kstep;
            const char* a2 = last ? nA : cA + (size_t)(t + 2) * kstep; const char* b2 = last ? nB : cB + (size_t)(t + 2) * kstep;
            const char* a3 = a2 + kstep; const char* b3 = b2 + kstep;
            if (last && has_next) S.a_ready(nxt);
            if constexpr (SP2) {
            PG8_LDB(B0, 0, 0); PG8_LDB(B1, 0, 1); PG8_SCHED; PG8_LDA(At, 0, 0); PG8_STAGE(PG8_SA(1, 1), a1 + hstep, voffA);
            PG8_WAIT_V(8); PG8_WAIT_L(0); PG8_BAR; PG8_MMA(0, 0, At, B0); PG8_MMA(0, 1, At, B1); PG8_BAR; PG8_SCHED;
            PG8_LDA(At, 0, 1); PG8_STAGE(PG8_SB(0, 0), b2, voffB); PG8_STAGE(PG8_SB(0, 1), b2 + hstep, voffB); PG8_STAGE(PG8_SA(0, 0), a2, voffA);
            PG8_WAIT_V(8); PG8_WAIT_L(0); PG8_BAR; PG8_MMA(1, 0, At, B0); PG8_MMA(1, 1, At, B1); PG8_BAR; PG8_SCHED;
            PG8_LDB(B0, 1, 0); PG8_LDB(B1, 1, 1); PG8_SCHED; PG8_LDA(At, 1, 0); PG8_STAGE(PG8_SA(0, 1), a2 + hstep, voffA);
            PG8_WAIT_V(8); PG8_WAIT_L(0); PG8_BAR; PG8_MMA(0, 0, At, B0); PG8_MMA(0, 1, At, B1); PG8_BAR; PG8_SCHED;
            PG8_LDA(At, 1, 1); PG8_STAGE(PG8_SB(1, 0), b3, voffB); PG8_STAGE(PG8_SB(1, 1), b3 + hstep, voffB); PG8_STAGE(PG8_SA(1, 0), a3, voffA);
            PG8_WAIT_V(8); PG8_WAIT_L(0); PG8_BAR; PG8_MMA(1, 0, At, B0); PG8_MMA(1, 1, At, B1); PG8_BAR; PG8_SCHED;
            } else {
            PG8_LDB(B0, 0, 0); PG8_SCHED; PG8_LDA(At, 0, 0); PG8_STAGE(PG8_SA(1, 1), a1 + hstep, voffA);
            PG8_WAIT_L(8); PG8_BAR; PG8_WAIT_L(0); PG8_MMA(0, 0, At, B0); PG8_BAR; PG8_SCHED;
            PG8_LDB(B1, 0, 1); PG8_STAGE(PG8_SB(0, 0), b2, voffB);
            PG8_BAR; PG8_WAIT_L(0); PG8_MMA(0, 1, At, B1); PG8_BAR;
            PG8_LDA(At, 0, 1); PG8_STAGE(PG8_SA(0, 0), a2, voffA);
            PG8_BAR; PG8_WAIT_L(0); PG8_MMA(1, 0, At, B0); PG8_BAR; PG8_SCHED;
            PG8_STAGE(PG8_SB(0, 1), b2 + hstep, voffB);
            PG8_WAIT_V(6); PG8_BAR; PG8_MMA(1, 1, At, B1); PG8_BAR;
            PG8_LDB(B0, 1, 0); PG8_SCHED; PG8_LDA(At, 1, 0); PG8_STAGE(PG8_SA(0, 1), a2 + hstep, voffA);
            PG8_WAIT_L(8); PG8_BAR; PG8_WAIT_L(0); PG8_MMA(0, 0, At, B0); PG8_BAR; PG8_SCHED;
            PG8_LDB(B1, 1, 1); PG8_STAGE(PG8_SB(1, 0), b3, voffB);
            PG8_BAR; PG8_WAIT_L(0); PG8_MMA(0, 1, At, B1); PG8_BAR;
            PG8_LDA(At, 1, 1); PG8_STAGE(PG8_SA(1, 0), a3, voffA);
            PG8_BAR; PG8_WAIT_L(0); PG8_MMA(1, 0, At, B0); PG8_BAR; PG8_SCHED;
            PG8_STAGE(PG8_SB(1, 1), b3 + hstep, voffB);
            PG8_WAIT_V(6); PG8_BAR; PG8_MMA(1, 1, At, B1); PG8_BAR;
            }
        }
        if constexpr (ALIGN_EPI) { if (wr == 0) PG8_BAR; }
        if constexpr (!Epi::AFTER_DRAIN) { E(acc, cur, wr, wc, fr, fq); S.done(cur); }
        if (!has_next) break;
#pragma unroll
        for (int a = 0; a < 2; ++a)
#pragma unroll
            for (int b = 0; b < 2; ++b)
#pragma unroll
                for (int m = 0; m < 4; ++m)
#pragma unroll
                    for (int n = 0; n < 2; ++n) acc[a][b][m][n] = (f32x4){0.f, 0.f, 0.f, 0.f};
        cur = nxt; cA = nA; cB = nB; ++ui;
        if constexpr (ALIGN_EPI) { if (wr == 1) PG8_BAR; }
    }
    PG8_WAIT_V(0);
    if constexpr (!ALIGN_EPI) { if (wr == 0) PG8_BAR; }
    PG8_BAR;
    if constexpr (Epi::AFTER_DRAIN) { E.fused(acc, cur, wr, wc, fr, fq, lds, wid, lane); S.done(cur); }
#undef PG8_SA
#undef PG8_SB
#undef PG8_STAGE
#undef PG8_LDA
#undef PG8_LDB
#undef PG8_MMA
#undef PG8_WAIT_V
#undef PG8_WAIT_L
#undef PG8_BAR
#undef PG8_SCHED
}
}

typedef unsigned short bf16_t;
using pg8::f32x4; using pg8::bf16x8; using pg8::u32x4; using pg8::cvt_pk_bf16;
typedef short s16x4 __attribute__((ext_vector_type(4)));
typedef unsigned u32x2 __attribute__((ext_vector_type(2)));
#define LAS __attribute__((address_space(3)))
constexpr int NB = 4, T = 8192, D = 1024, M = NB * T, NTHR = 512;
constexpr size_t MiB = 1u << 20;
constexpr size_t WS_MOD = 0, WS_BAR = 512 * 1024, WS_BONUS = 1 * MiB, WS_WA = 3 * MiB, WS_WB = 12 * MiB, WS_WC = 20 * MiB, WS_W2 = 24 * MiB, WS_WOR = 27 * MiB, WS_WOA = 29 * MiB,
                 WS_WOUT = 30 * MiB, WS_WFI = 32 * MiB, WS_WFO = 43 * MiB;
constexpr size_t WS_HB = 50 * MiB, WS_QKVA = 114 * MiB, WS_OATT = 442 * MiB;
constexpr size_t WS_PRKV = 114 * MiB, WS_P = 306 * MiB, WS_A2 = 354 * MiB, WS_WLOG = 378 * MiB, WS_Y = 306 * MiB;
constexpr size_t WS_T1 = 242 * MiB, WS_MIXIN = 114 * MiB, WS_MIXED = 378 * MiB;
constexpr size_t WS_U = 114 * MiB, WS_Y2 = 290 * MiB, WS_END = 512 * MiB;
constexpr size_t OUT_OG = 0, OUT_LSE = 96 * MiB, OUT_ASIG = 0, OUT_GG = 64 * MiB;
constexpr int LDS_BYTES = 147456;
constexpr int NPHASE = 18;

struct Args { const float* in[29]; float* out; unsigned char* ws; int ph_lo, ph_hi; };

__device__ __forceinline__ float bf2f(bf16_t v) { return __uint_as_float(((unsigned)v) << 16); }
__device__ __forceinline__ bf16_t f2bf(float f) { unsigned u = __float_as_uint(f); u += 0x7FFFu + ((u >> 16) & 1u); return (bf16_t)(u >> 16); }
__device__ __forceinline__ float lo_bf(unsigned u) { return __uint_as_float(u << 16); }
__device__ __forceinline__ float hi_bf(unsigned u) { return __uint_as_float(u & 0xffff0000u); }
__device__ __forceinline__ float sigmoidf_(float x) { return __builtin_amdgcn_rcpf(1.0f + __expf(-x)); }
__device__ __forceinline__ float wave_sum(float v) {
#pragma unroll
    for (int o = 32; o >= 1; o >>= 1) v += __shfl_xor(v, o);
    return v;
}
__device__ __forceinline__ unsigned pk_f16(float a, float b) {
    const _Float16 ha = (_Float16)a, hb = (_Float16)b;
    return (unsigned)__builtin_bit_cast(unsigned short, ha) | ((unsigned)__builtin_bit_cast(unsigned short, hb) << 16);
}
__device__ __forceinline__ float f16_to_f(unsigned short h) { return (float)__builtin_bit_cast(_Float16, h); }

enum { EP_PLAIN = 0, EP_SPLIT = 1, EP_L2W = 2, EP_SIG = 3, EP_MULG = 4, EP_MIX = 5, EP_SWIGLU = 6, EP_L2A = 7, EP_L2 = 8, EP_QKV = 9 };
template <int MODE> struct Epi {
    static constexpr bool PERM = true, AFTER_DRAIN = false;
    bf16_t* O; int ldc; bf16_t* O2; bf16_t* O3; const bf16_t* G; const bf16_t* G2; const float* v0; const float* v1;
    __device__ __forceinline__ void operator()(const f32x4 (&acc)[2][2][4][2], const pg8::Unit& u, int wr, int wc, int fr, int fq) const {
        const int row0 = u.pm * 256 + wr * 64 + fr, cin = wc * 32 + 8 * fq;
#pragma unroll
        for (int ai = 0; ai < 2; ++ai)
#pragma unroll
            for (int m = 0; m < 4; ++m) {
                const size_t row = (size_t)(row0 + ai * 128 + m * 16);
                if constexpr (MODE == EP_SWIGLU) {
                    const f32x4 g0 = acc[ai][0][m][0], g1 = acc[ai][0][m][1], u0 = acc[ai][1][m][0], u1 = acc[ai][1][m][1];
                    float r[8];
#pragma unroll
                    for (int j = 0; j < 4; ++j) { r[j] = g0[j] * sigmoidf_(g0[j]) * u0[j]; r[4 + j] = g1[j] * sigmoidf_(g1[j]) * u1[j]; }
                    u32x4 w; w.x = cvt_pk_bf16(r[0], r[1]); w.y = cvt_pk_bf16(r[2], r[3]); w.z = cvt_pk_bf16(r[4], r[5]); w.w = cvt_pk_bf16(r[6], r[7]);
                    *(u32x4*)(O + row * ldc + u.pn * 128 + cin) = w;
                } else {
#pragma unroll
                    for (int bj = 0; bj < 2; ++bj) {
                        const int col = u.pn * 256 + bj * 128 + cin;
                        const f32x4 a0 = acc[ai][bj][m][0], a1 = acc[ai][bj][m][1];
                        float r[8] = {a0[0], a0[1], a0[2], a0[3], a1[0], a1[1], a1[2], a1[3]};
                        bf16_t* dst = O + row * ldc + col;
                        if constexpr (MODE == EP_SPLIT) { if (col >= 3072) dst = O2 + row * 768 + (col - 3072); }
                        if constexpr (MODE == EP_QKV) {
                            const int sg = u.pn >> 1, g = sg % 3, hh = (u.pn & 1) * 4 + ((bj * 128 + cin) >> 6), dd = cin & 63;
                            const int bb = (int)(row >> 13), t = (int)row & (T - 1), dsh = 2 * g, r = t & ((1 << dsh) - 1), uu = t >> dsh;
                            dst = O + ((((size_t)(sg * 8 + hh) * 4 + bb) * T + (size_t)r * (T >> dsh) + uu) << 6) + dd;
                        }
                        if constexpr (MODE == EP_SIG) {
#pragma unroll
                            for (int j = 0; j < 8; ++j) r[j] = sigmoidf_(r[j]);
                            dst = (col < 1024) ? (O + row * 1024 + col) : (O2 + row * 1024 + (col - 1024));
                        }
                        if constexpr (MODE == EP_MULG) {
                            const u32x4 gv = *(const u32x4*)(G + row * 1024 + col);
                            r[0] *= lo_bf(gv.x); r[1] *= hi_bf(gv.x); r[2] *= lo_bf(gv.y); r[3] *= hi_bf(gv.y); r[4] *= lo_bf(gv.z); r[5] *= hi_bf(gv.z); r[6] *= lo_bf(gv.w); r[7] *= hi_bf(gv.w);
                        }
                        if constexpr (MODE == EP_MIX) {
                            const u32x4 gv = *(const u32x4*)(G + row * 1024 + col);
                            const u32x4 tv = *(const u32x4*)(G2 + row * 1024 + col);
                            r[0] = lo_bf(tv.x) + r[0] * lo_bf(gv.x); r[1] = hi_bf(tv.x) + r[1] * hi_bf(gv.x); r[2] = lo_bf(tv.y) + r[2] * lo_bf(gv.y); r[3] = hi_bf(tv.y) + r[3] * hi_bf(gv.y);
                            r[4] = lo_bf(tv.z) + r[4] * lo_bf(gv.z); r[5] = hi_bf(tv.z) + r[5] * hi_bf(gv.z); r[6] = lo_bf(tv.w) + r[6] * lo_bf(gv.w); r[7] = hi_bf(tv.w) + r[7] * hi_bf(gv.w);
                        }
                        if constexpr (MODE == EP_L2) {
                            const int region = u.pn >> 2, cc = col - 1024 * region;
                            if (region == 0) {
                                const f32x4 b0 = *(const f32x4*)(v0 + cc), b1 = *(const f32x4*)(v0 + cc + 4);
                                const float z[8] = {b0[0], b0[1], b0[2], b0[3], b1[0], b1[1], b1[2], b1[3]};
#pragma unroll
                                for (int j = 0; j < 8; ++j) r[j] = 1.0f - __expf(-0.6065306597126334f * sigmoidf_(z[j] + r[j]));
                                u32x4 w; w.x = pk_f16(r[0], r[1]); w.y = pk_f16(r[2], r[3]); w.z = pk_f16(r[4], r[5]); w.w = pk_f16(r[6], r[7]);
                                *(u32x4*)(O + row * 1024 + cc) = w;
                                continue;
                            } else if (region == 1) {
                                const f32x4 b0 = *(const f32x4*)(v1 + cc), b1 = *(const f32x4*)(v1 + cc + 4);
                                const float z[8] = {b0[0], b0[1], b0[2], b0[3], b1[0], b1[1], b1[2], b1[3]};
#pragma unroll
                                for (int j = 0; j < 8; ++j) r[j] = sigmoidf_(z[j] + r[j]);
                                dst = O2 + row * 1024 + cc;
                            } else dst = O3 + row * 1024 + cc;
                        }
                        if constexpr (MODE == EP_L2W) {
                            const f32x4 b0 = *(const f32x4*)(v0 + col), b1 = *(const f32x4*)(v0 + col + 4);
                            const float z[8] = {b0[0], b0[1], b0[2], b0[3], b1[0], b1[1], b1[2], b1[3]};
#pragma unroll
                            for (int j = 0; j < 8; ++j) r[j] = 1.0f - __expf(-0.6065306597126334f * sigmoidf_(z[j] + r[j]));
                            u32x4 w; w.x = pk_f16(r[0], r[1]); w.y = pk_f16(r[2], r[3]); w.z = pk_f16(r[4], r[5]); w.w = pk_f16(r[6], r[7]);
                            *(u32x4*)dst = w;
                            continue;
                        }
                        if constexpr (MODE == EP_L2A) {
                            const f32x4 b0 = *(const f32x4*)(v0 + col), b1 = *(const f32x4*)(v0 + col + 4);
                            const float z[8] = {b0[0], b0[1], b0[2], b0[3], b1[0], b1[1], b1[2], b1[3]};
#pragma unroll
                            for (int j = 0; j < 8; ++j) r[j] = sigmoidf_(z[j] + r[j]);
                        }
                        u32x4 w; w.x = cvt_pk_bf16(r[0], r[1]); w.y = cvt_pk_bf16(r[2], r[3]); w.z = cvt_pk_bf16(r[4], r[5]); w.w = cvt_pk_bf16(r[6], r[7]);
                        *(u32x4*)dst = w;
                    }
                }
            }
    }
};
template <int MODE> __device__ __forceinline__ void run_gemm(LAS unsigned char* lds, const bf16_t* A, const bf16_t* Bt, int N, int K, const Epi<MODE>& E) {
    pg8::Gemm g{A, Bt, M, N, K}; pg8::StaticOrder S; S.init(M, N, (int)gridDim.x, (int)blockIdx.x);
    pg8::gemm_phase<Epi<MODE>, pg8::StaticOrder, true, true>(lds, g, S, E);
}

#define XB_TMO      128
#define XB_XCNT(j)  (256  + 64 * (j))
#define XB_XSUB(j)  (1280 + 64 * (j))
#define XB_XGEN(j)  (2304 + 64 * (j))
#define XB_TOP      3328
#define XB_TOPGEN   3392
#define XCD_BAR_WORDS 3456
#define XB_SPIN_CAP (1u << 18)

__device__ __forceinline__ unsigned xb_ld(unsigned* p)              { return __hip_atomic_load(p, __ATOMIC_RELAXED, __HIP_MEMORY_SCOPE_AGENT); }
__device__ __forceinline__ unsigned xb_add(unsigned* p, unsigned v) { return __hip_atomic_fetch_add(p, v, __ATOMIC_RELAXED, __HIP_MEMORY_SCOPE_AGENT); }
__device__ __forceinline__ unsigned xb_xcc_id() { return (unsigned)__builtin_amdgcn_s_getreg((3 << 11) | 20) & 0xFu; }
#define XB_SPIN(cond, bar) do { unsigned _sp = 0; while (cond) { __builtin_amdgcn_s_sleep(1); \
    if ((++_sp & 255u) == 0u) { if (xb_ld(&(bar)[XB_TMO])) break; if (_sp > XB_SPIN_CAP) { atomicAdd(&(bar)[XB_TMO], 1u); break; } } } } while (0)

struct XcdBarrier {
    unsigned* bar; unsigned x;
    volatile LAS unsigned* st;
};

__device__ __forceinline__ XcdBarrier xcd_barrier_post(unsigned* bar, volatile LAS unsigned* st) {
    XcdBarrier b; b.bar = bar; b.x = xb_xcc_id(); b.st = st;
    if (threadIdx.x == 0) (void)xb_add(&bar[XB_XCNT(b.x)], 1u);
    return b;
}
__device__ __forceinline__ void xcd_barrier_complete(unsigned* bar, unsigned x, unsigned& nloc, unsigned& nx) {
    const unsigned G = gridDim.x * gridDim.y * gridDim.z;
    unsigned sum, cnt, mine, sp = 0u;
    for (;;) {
        sum = 0u; cnt = 0u; mine = 0u;
#pragma unroll
        for (unsigned j = 0; j < 16; ++j) { const unsigned c = xb_ld(&bar[XB_XCNT(j)]); sum += c; cnt += (c > 0u) ? 1u : 0u; mine = (j == x) ? c : mine; }
        if (sum == G) break;
        __builtin_amdgcn_s_sleep(1);
        if ((++sp & 255u) == 0u) { if (xb_ld(&bar[XB_TMO])) break; if (sp > XB_SPIN_CAP) { atomicAdd(&bar[XB_TMO], 1u); break; } }
    }
    nloc = mine > 0u ? mine : 1u; nx = cnt > 0u ? cnt : 1u;
}

__device__ __forceinline__ void xcd_barrier(const XcdBarrier& b) {
    asm volatile("s_waitcnt vmcnt(0)" ::: "memory");
    __syncthreads();
    if (threadIdx.x == 0) {
        unsigned* bar = b.bar;
        __builtin_amdgcn_s_waitcnt(0);
        unsigned nloc = b.st[0], nx = b.st[1];
        if (nloc == 0u) { xcd_barrier_complete(bar, b.x, nloc, nx); b.st[0] = nloc; b.st[1] = nx; }
        const unsigned old = xb_add(&bar[XB_XSUB(b.x)], 1u);
        const unsigned gen = old / nloc;
        if (old + 1u == (gen + 1u) * nloc) {
            __builtin_amdgcn_fence(__ATOMIC_RELEASE, "agent");
            asm volatile("s_waitcnt vmcnt(0)" ::: "memory");
            const unsigned og = xb_add(&bar[XB_TOP], 1u);
            const unsigned tg = og / nx;
            if (og + 1u == (tg + 1u) * nx) xb_add(&bar[XB_TOPGEN], 1u);
            else XB_SPIN(xb_ld(&bar[XB_TOPGEN]) == tg, bar);
            __builtin_amdgcn_fence(__ATOMIC_ACQUIRE, "agent");
            xb_add(&bar[XB_XGEN(b.x)], 1u);
            asm volatile("s_waitcnt vmcnt(0)" ::: "memory");
        } else {
            XB_SPIN(xb_ld(&bar[XB_XGEN(b.x)]) == gen, bar);
            __builtin_amdgcn_fence(__ATOMIC_ACQUIRE, "agent");
            asm volatile("s_waitcnt vmcnt(0)" ::: "memory");
        }
    }
    __syncthreads();
}


constexpr int TRP = 129;
struct TrJob { const float* src; int ld, c0, ncols, K; bf16_t* dst; int ldd, drow0, dk0; const float* rs; int rsmode; float cscale; };
__device__ __forceinline__ void tile_load(const TrJob& j, int t, float (&v)[16]) {
    const int tid = threadIdx.x, cc = tid & 127, kb = tid >> 7;
    const int nct = (j.ncols + 127) >> 7, ct = t % nct, k0 = (t / nct) * 64;
    int nc = j.ncols - ct * 128; if (nc > 128) nc = 128;
    const float* s = j.src + j.c0 + ct * 128 + cc;
#pragma unroll
    for (int p = 0; p < 16; ++p) { const int kk = k0 + kb + 4 * p; v[p] = (kk < j.K && cc < nc) ? s[(size_t)kk * j.ld] : 0.f; }
    if (j.rs) {
#pragma unroll
        for (int p = 0; p < 16; ++p) { const int kk = k0 + kb + 4 * p; if (kk < j.K) { const float mu = j.rs[kk]; v[p] *= j.rsmode ? mu : (1.0f - mu); } }
    }
}
__device__ __forceinline__ void tile_finish(LAS float* tile, const TrJob& j, int t, const float (&v)[16]) {
    const int tid = threadIdx.x, cc = tid & 127, kb = tid >> 7;
    const int nct = (j.ncols + 127) >> 7, ct = t % nct, k0 = (t / nct) * 64;
    int nc = j.ncols - ct * 128; if (nc > 128) nc = 128;
    __syncthreads();
#pragma unroll
    for (int p = 0; p < 16; ++p) tile[(kb + 4 * p) * TRP + cc] = v[p] * j.cscale;
    __syncthreads();
    const int n = tid >> 2, ks = tid & 3;
    if (n < nc) {
#pragma unroll
        for (int hf = 0; hf < 2; ++hf) {
            const int kq = ks * 16 + hf * 8;
            if (k0 + kq < j.K) {
                float r[8];
#pragma unroll
                for (int q = 0; q < 8; ++q) r[q] = tile[(kq + q) * TRP + n];
                u32x4 w; w.x = cvt_pk_bf16(r[0], r[1]); w.y = cvt_pk_bf16(r[2], r[3]); w.z = cvt_pk_bf16(r[4], r[5]); w.w = cvt_pk_bf16(r[6], r[7]);
                *(u32x4*)(j.dst + (size_t)(j.drow0 + ct * 128 + n) * j.ldd + j.dk0 + k0 + kq) = w;
            }
        }
    }
}
constexpr int NTILES = 2760;
__device__ __forceinline__ void tile_decode(const Args& a, int g, TrJob& j, int& t) {
    unsigned char* ws = a.ws; const float* w_in = a.in[8]; const float* mu = a.in[10];
    bf16_t* WA = (bf16_t*)(ws + WS_WA); bf16_t* WB = (bf16_t*)(ws + WS_WB); bf16_t* W2 = (bf16_t*)(ws + WS_W2);
    const float QS = 0.125f * 1.4426950408889634f;
    if (g < 192) { j = TrJob{w_in, 9728, 3072, 1536, 1024, WA, 1024, 0, 0, nullptr, 0, QS}; t = g; return; } g -= 192;
    if (g < 384) { j = TrJob{w_in, 9728, 4608, 3072, 1024, WA, 1024, 1536, 0, nullptr, 0, 1.0f}; t = g; return; } g -= 384;
    if (g < 384) { j = TrJob{w_in, 9728, 0, 3072, 1024, WB, 1024, 0, 0, nullptr, 0, 1.0f}; t = g; return; } g -= 384;
    if (g < 16) { j = TrJob{a.in[12], 64, 0, 64, 1024, WB, 1024, 3072, 0, mu, 0, 1.0f}; t = g; return; } g -= 16;
    if (g < 16) { j = TrJob{a.in[15], 64, 0, 64, 1024, WB, 1024, 3136, 0, mu + 1024, 0, 1.0f}; t = g; return; } g -= 16;
    if (g < 32) { j = TrJob{a.in[17], 160, 0, 160, 1024, WB, 1024, 3200, 0, mu + 2048, 0, 1.0f}; t = g; return; } g -= 32;
    if (g < 16) { j = TrJob{a.in[12], 64, 0, 64, 1024, WB, 1024, 3360, 0, mu, 1, 1.0f}; t = g; return; } g -= 16;
    if (g < 16) { j = TrJob{a.in[15], 64, 0, 64, 1024, WB, 1024, 3424, 0, mu + 1024, 1, 1.0f}; t = g; return; } g -= 16;
    if (g < 32) { j = TrJob{a.in[17], 160, 0, 160, 1024, WB, 1024, 3488, 0, mu + 2048, 1, 1.0f}; t = g; return; } g -= 32;
    if (g < 256) { j = TrJob{w_in, 9728, 7680, 2048, 1024, (bf16_t*)(ws + WS_WC), 1024, 0, 0, nullptr, 0, 1.0f}; t = g; return; } g -= 256;
    if (g < 128) { j = TrJob{a.in[24], 1024, 0, 1024, 1024, (bf16_t*)(ws + WS_WOR), 1024, 0, 0, nullptr, 0, 1.0f}; t = g; return; } g -= 128;
    if (g < 64) { j = TrJob{a.in[25], 1024, 0, 1024, 512, (bf16_t*)(ws + WS_WOA), 512, 0, 0, nullptr, 0, 1.0f}; t = g; return; } g -= 64;
    if (g < 128) { j = TrJob{a.in[26], 1024, 0, 1024, 1024, (bf16_t*)(ws + WS_WOUT), 1024, 0, 0, nullptr, 0, 1.0f}; t = g; return; } g -= 128;
    if (g < 352) { j = TrJob{a.in[28], 1024, 0, 1024, 2816, (bf16_t*)(ws + WS_WFO), 2816, 0, 0, nullptr, 0, 1.0f}; t = g; return; } g -= 352;
    if (g < 704) { const int s = g >> 4, pn = s >> 1, bj = s & 1;
                   j = TrJob{a.in[27], 5632, bj * 2816 + pn * 128, 128, 1024, (bf16_t*)(ws + WS_WFI), 1024, pn * 256 + bj * 128, 0, nullptr, 0, 1.0f}; t = g & 15; return; } g -= 704;
    if (g < 8) { j = TrJob{a.in[13], 1024, 0, 1024, 64, W2, 384, 0, 0, nullptr, 0, 1.0f}; t = g; return; } g -= 8;
    if (g < 8) { j = TrJob{a.in[16], 1024, 0, 1024, 64, W2, 384, 1024, 64, nullptr, 0, 1.0f}; t = g; return; } g -= 8;
    j = TrJob{a.in[18], 1024, 0, 1024, 160, W2, 384, 2048, 128, nullptr, 0, 1.0f}; t = g;
}
__device__ __forceinline__ void p0_prologue(const Args& a, LAS unsigned char* lds) {
    LAS float* tile = (LAS float*)lds;
    unsigned char* ws = a.ws;
    const int tid = threadIdx.x, G = gridDim.x, bx = blockIdx.x;
    const float* w_in = a.in[8]; const float* mu_lora = a.in[10];
    bf16_t* WA = (bf16_t*)(ws + WS_WA); bf16_t* WB = (bf16_t*)(ws + WS_WB); bf16_t* WC = (bf16_t*)(ws + WS_WC); bf16_t* W2 = (bf16_t*)(ws + WS_W2);
    {
        const float* c = a.in[1]; const float* w_mod = a.in[2]; const float* b_mod = a.in[3];
        float* MOD = (float*)(ws + WS_MOD);
        LAS float* red = (LAS float*)lds;
        for (int cb = bx; cb < 256; cb += G) {
            const int col = tid % 24, kg = tid / 24;
            float s0 = 0.f, s1 = 0.f, s2 = 0.f, s3 = 0.f;
            if (kg < 21)
#pragma unroll 7
            for (int k = kg; k < 1024; k += 21) { const float w = w_mod[(size_t)k * 6144 + cb * 24 + col]; s0 += c[k] * w; s1 += c[1024 + k] * w; s2 += c[2048 + k] * w; s3 += c[3072 + k] * w; }
            __syncthreads();
            if (kg < 21) { red[(kg * 24 + col) * 4 + 0] = s0; red[(kg * 24 + col) * 4 + 1] = s1; red[(kg * 24 + col) * 4 + 2] = s2; red[(kg * 24 + col) * 4 + 3] = s3; }
            __syncthreads();
            if (tid < 96) { const int cc = tid % 24, b = tid / 24; float s = 0.f; for (int g = 0; g < 21; ++g) s += red[(g * 24 + cc) * 4 + b]; MOD[b * 6144 + cb * 24 + cc] = s + b_mod[cb * 24 + cc]; }
        }
        __syncthreads();
    }
    {
        int g = bx, t = 0, tn = 0; TrJob j{}, jn{}; float v[16], vn[16];
        if (g < NTILES) { tile_decode(a, g, j, t); tile_load(j, t, v); }
        while (g < NTILES) {
            const int gn = g + G;
            if (gn < NTILES) { tile_decode(a, gn, jn, tn); tile_load(jn, tn, vn); }
            tile_finish(tile, j, t, v);
            j = jn; t = tn; g = gn;
#pragma unroll
            for (int p2 = 0; p2 < 16; ++p2) v[p2] = vn[p2];
        }
    }
    for (int i = bx * NTHR + tid; i < 192 * 1024 / 8; i += G * NTHR) ((u32x4*)(WB + (size_t)3648 * 1024))[i] = (u32x4){0u, 0u, 0u, 0u};
    for (int i = bx * NTHR + tid; i < 1024 * 108; i += G * NTHR) {
        const int row = i / 108, c = i % 108;
        int n, k8;
        if (c < 40) { n = row; k8 = 8 + c; }
        else if (c < 80) { n = 1024 + row; k8 = (c - 40) < 8 ? (c - 40) : (c - 40) + 8; }
        else { n = 2048 + row; k8 = (c - 80) < 16 ? (c - 80) : (c - 80) + 20; }
        *(u32x4*)(W2 + (size_t)n * 384 + k8 * 8) = (u32x4){0u, 0u, 0u, 0u};
    }
}

constexpr int RPW = 16;
__device__ __forceinline__ void p1_prenorm(const Args& a) {
    const int lane = threadIdx.x & 63, wave = threadIdx.x >> 6;
    const float* x = a.in[0]; const float* gpre = a.in[4]; const float* MOD = (const float*)(a.ws + WS_MOD); bf16_t* HB = (bf16_t*)(a.ws + WS_HB);
    for (int base = (blockIdx.x * 8 + wave) * RPW; base < M; base += gridDim.x * 8 * RPW) {
        const float* mod = MOD + (base / T) * 6144;
        f32x4 g[4], sh[4], sc[4];
#pragma unroll
        for (int i = 0; i < 4; ++i) { const int c = i * 256 + lane * 4; g[i] = *(const f32x4*)(gpre + c); sh[i] = *(const f32x4*)(mod + c); sc[i] = *(const f32x4*)(mod + 1024 + c) + 1.0f; }
        f32x4 v[4];
#pragma unroll
        for (int i = 0; i < 4; ++i) v[i] = ((const f32x4*)(x + (size_t)base * D))[i * 64 + lane];
#pragma unroll 2
        for (int k = 0; k < RPW; ++k) {
            const int row = base + k, rn = (k + 1 < RPW) ? row + 1 : row;
            f32x4 vn[4];
#pragma unroll
            for (int i = 0; i < 4; ++i) vn[i] = ((const f32x4*)(x + (size_t)rn * D))[i * 64 + lane];
            float ss = 0.f;
#pragma unroll
            for (int i = 0; i < 4; ++i) ss += v[i][0] * v[i][0] + v[i][1] * v[i][1] + v[i][2] * v[i][2] + v[i][3] * v[i][3];
            ss = wave_sum(ss);
            const float rs = rsqrtf(ss * (1.0f / D) + 1e-6f);
#pragma unroll
            for (int i = 0; i < 4; ++i) {
                float r[4];
#pragma unroll
                for (int j = 0; j < 4; ++j) r[j] = (v[i][j] * rs * g[i][j]) * sc[i][j] + sh[i][j];
                u32x2 w; w.x = cvt_pk_bf16(r[0], r[1]); w.y = cvt_pk_bf16(r[2], r[3]);
                *(u32x2*)(HB + (size_t)row * D + i * 256 + lane * 4) = w;
            }
#pragma unroll
            for (int i = 0; i < 4; ++i) v[i] = vn[i];
        }
    }
}
__device__ __forceinline__ void p13_mid(const Args& a) {
    const int lane = threadIdx.x & 63, wave = threadIdx.x >> 6;
    const float* x = a.in[0]; const float* gpost = a.in[5]; const float* gpre2 = a.in[6]; const float* MOD = (const float*)(a.ws + WS_MOD);
    const bf16_t* MX = (const bf16_t*)(a.ws + WS_MIXED); bf16_t* HB = (bf16_t*)(a.ws + WS_HB); float* out = a.out;
    for (int base = (blockIdx.x * 8 + wave) * RPW; base < M; base += gridDim.x * 8 * RPW) {
        const float* mod = MOD + (base / T) * 6144;
        f32x4 gg[4], g2[4], sh[4], sc[4];
#pragma unroll
        for (int i = 0; i < 4; ++i) { const int c = i * 256 + lane * 4; gg[i] = *(const f32x4*)(gpost + c) * *(const f32x4*)(mod + 2048 + c); g2[i] = *(const f32x4*)(gpre2 + c);
                                      sh[i] = *(const f32x4*)(mod + 3072 + c); sc[i] = *(const f32x4*)(mod + 4096 + c) + 1.0f; }
        u32x2 m[4]; f32x4 xv[4];
#pragma unroll
        for (int i = 0; i < 4; ++i) { m[i] = *(const u32x2*)(MX + (size_t)base * D + i * 256 + lane * 4); xv[i] = *(const f32x4*)(x + (size_t)base * D + i * 256 + lane * 4); }
#pragma unroll 2
        for (int k = 0; k < RPW; ++k) {
            const int row = base + k, rn = (k + 1 < RPW) ? row + 1 : row;
            u32x2 mn[4]; f32x4 xn[4];
#pragma unroll
            for (int i = 0; i < 4; ++i) { mn[i] = *(const u32x2*)(MX + (size_t)rn * D + i * 256 + lane * 4); xn[i] = *(const f32x4*)(x + (size_t)rn * D + i * 256 + lane * 4); }
            f32x4 v[4]; float ss = 0.f;
#pragma unroll
            for (int i = 0; i < 4; ++i) { v[i] = (f32x4){lo_bf(m[i].x), hi_bf(m[i].x), lo_bf(m[i].y), hi_bf(m[i].y)}; ss += v[i][0] * v[i][0] + v[i][1] * v[i][1] + v[i][2] * v[i][2] + v[i][3] * v[i][3]; }
            ss = wave_sum(ss);
            const float rs = rsqrtf(ss * (1.0f / D) + 1e-6f);
            float ss2 = 0.f;
#pragma unroll
            for (int i = 0; i < 4; ++i) {
#pragma unroll
                for (int j = 0; j < 4; ++j) { v[i][j] = xv[i][j] + gg[i][j] * (v[i][j] * rs); ss2 += v[i][j] * v[i][j]; }
            }
            ss2 = wave_sum(ss2);
            const float rs2 = rsqrtf(ss2 * (1.0f / D) + 1e-6f);
#pragma unroll
            for (int i = 0; i < 4; ++i) {
                float r[4];
#pragma unroll
                for (int j = 0; j < 4; ++j) r[j] = (v[i][j] * rs2 * g2[i][j]) * sc[i][j] + sh[i][j];
                u32x2 w; w.x = cvt_pk_bf16(r[0], r[1]); w.y = cvt_pk_bf16(r[2], r[3]);
                *(u32x2*)(HB + (size_t)row * D + i * 256 + lane * 4) = w;
            }
#pragma unroll
            for (int i = 0; i < 4; ++i) { m[i] = mn[i]; xv[i] = xn[i]; }
        }
    }
}
__device__ __forceinline__ void p16_final(const Args& a) {
    const int lane = threadIdx.x & 63, wave = threadIdx.x >> 6;
    const float* x = a.in[0]; const float* gpm = a.in[5]; const float* gpost = a.in[7]; const float* MOD = (const float*)(a.ws + WS_MOD);
    const bf16_t* MX = (const bf16_t*)(a.ws + WS_MIXED); const bf16_t* Y2 = (const bf16_t*)(a.ws + WS_Y2); float* out = a.out;
    for (int base = (blockIdx.x * 8 + wave) * RPW; base < M; base += gridDim.x * 8 * RPW) {
        const float* mod = MOD + (base / T) * 6144;
        f32x4 gm[4], gg[4];
#pragma unroll
        for (int i = 0; i < 4; ++i) { const int c = i * 256 + lane * 4; gm[i] = *(const f32x4*)(gpm + c) * *(const f32x4*)(mod + 2048 + c); gg[i] = *(const f32x4*)(gpost + c) * *(const f32x4*)(mod + 5120 + c); }
        u32x2 m[4], y[4]; f32x4 xv[4];
#pragma unroll
        for (int i = 0; i < 4; ++i) { const size_t o = (size_t)base * D + i * 256 + lane * 4; m[i] = *(const u32x2*)(MX + o); y[i] = *(const u32x2*)(Y2 + o); xv[i] = *(const f32x4*)(x + o); }
#pragma unroll 2
        for (int k = 0; k < RPW; ++k) {
            const int row = base + k, rn = (k + 1 < RPW) ? row + 1 : row;
            u32x2 mn[4], yn[4]; f32x4 xn[4];
#pragma unroll
            for (int i = 0; i < 4; ++i) { const size_t o = (size_t)rn * D + i * 256 + lane * 4; mn[i] = *(const u32x2*)(MX + o); yn[i] = *(const u32x2*)(Y2 + o); xn[i] = *(const f32x4*)(x + o); }
            f32x4 vm[4], vy[4]; float s1 = 0.f, s2 = 0.f;
#pragma unroll
            for (int i = 0; i < 4; ++i) { vm[i] = (f32x4){lo_bf(m[i].x), hi_bf(m[i].x), lo_bf(m[i].y), hi_bf(m[i].y)}; vy[i] = (f32x4){lo_bf(y[i].x), hi_bf(y[i].x), lo_bf(y[i].y), hi_bf(y[i].y)};
                s1 += vm[i][0] * vm[i][0] + vm[i][1] * vm[i][1] + vm[i][2] * vm[i][2] + vm[i][3] * vm[i][3]; s2 += vy[i][0] * vy[i][0] + vy[i][1] * vy[i][1] + vy[i][2] * vy[i][2] + vy[i][3] * vy[i][3]; }
            s1 = wave_sum(s1); s2 = wave_sum(s2);
            const float r1 = rsqrtf(s1 * (1.0f / D) + 1e-6f), r2 = rsqrtf(s2 * (1.0f / D) + 1e-6f);
#pragma unroll
            for (int i = 0; i < 4; ++i) {
                f32x4 o;
#pragma unroll
                for (int j = 0; j < 4; ++j) { const float x1 = xv[i][j] + gm[i][j] * (vm[i][j] * r1); o[j] = x1 + gg[i][j] * (vy[i][j] * r2); }
                *(f32x4*)(out + (size_t)row * D + i * 256 + lane * 4) = o;
            }
#pragma unroll
            for (int i = 0; i < 4; ++i) { m[i] = mn[i]; y[i] = yn[i]; xv[i] = xn[i]; }
        }
    }
}
__device__ __forceinline__ void p6_loramid(const Args& a) {
    const bf16_t* P = (const bf16_t*)(a.ws + WS_P); bf16_t* A2 = (bf16_t*)(a.ws + WS_A2);
    for (int i = blockIdx.x * NTHR + threadIdx.x; i < M * 192; i += gridDim.x * NTHR) {
        const int tok = i / 192, c = (i % 192) * 2;
        float h0 = 0.f, h1 = 0.f;
        if (c < 288) {
            const unsigned cur = *(const unsigned*)(P + (size_t)tok * 768 + c);
            h0 = lo_bf(cur); h1 = hi_bf(cur);
            if ((tok & (T - 1)) != 0) { const unsigned prv = *(const unsigned*)(P + (size_t)(tok - 1) * 768 + 288 + c); h0 += lo_bf(prv); h1 += hi_bf(prv); }
            if (c < 64) { h0 = 1.0f - 2.0f * __builtin_amdgcn_rcpf(__expf(2.0f * h0) + 1.0f); h1 = 1.0f - 2.0f * __builtin_amdgcn_rcpf(__expf(2.0f * h1) + 1.0f); }
            else if (c >= 128) { h0 = sigmoidf_(h0); h1 = sigmoidf_(h1); }
        }
        *(unsigned*)(A2 + (size_t)tok * 384 + c) = cvt_pk_bf16(h0, h1);
    }
}
__device__ __forceinline__ void p4_combine(const Args& a) {
    const bf16_t* OG = (const bf16_t*)((const unsigned char*)a.out + OUT_OG); const float* LSE = (const float*)((const unsigned char*)a.out + OUT_LSE);
    bf16_t* OATT = (bf16_t*)(a.ws + WS_OATT);
    for (int i = blockIdx.x * NTHR + threadIdx.x; i < M * 64; i += gridDim.x * NTHR) {
        const int tok = i >> 6, seg = i & 63, hh = seg >> 3;
        const float l0 = LSE[(size_t)tok * 8 + hh], l1 = LSE[(size_t)M * 8 + (size_t)tok * 8 + hh], l2 = LSE[(size_t)2 * M * 8 + (size_t)tok * 8 + hh];
        const float mx = fmaxf(l0, fmaxf(l1, l2));
        float w0 = __expf(l0 - mx), w1 = __expf(l1 - mx), w2 = __expf(l2 - mx);
        const float inv = __builtin_amdgcn_rcpf(w0 + w1 + w2); w0 *= inv; w1 *= inv; w2 *= inv;
        const u32x4 o0 = *(const u32x4*)(OG + (size_t)tok * 512 + seg * 8), o1 = *(const u32x4*)(OG + (size_t)M * 512 + (size_t)tok * 512 + seg * 8),
                    o2 = *(const u32x4*)(OG + (size_t)2 * M * 512 + (size_t)tok * 512 + seg * 8);
        u32x4 w;
        w.x = cvt_pk_bf16(w0 * lo_bf(o0.x) + w1 * lo_bf(o1.x) + w2 * lo_bf(o2.x), w0 * hi_bf(o0.x) + w1 * hi_bf(o1.x) + w2 * hi_bf(o2.x));
        w.y = cvt_pk_bf16(w0 * lo_bf(o0.y) + w1 * lo_bf(o1.y) + w2 * lo_bf(o2.y), w0 * hi_bf(o0.y) + w1 * hi_bf(o1.y) + w2 * hi_bf(o2.y));
        w.z = cvt_pk_bf16(w0 * lo_bf(o0.z) + w1 * lo_bf(o1.z) + w2 * lo_bf(o2.z), w0 * hi_bf(o0.z) + w1 * hi_bf(o1.z) + w2 * hi_bf(o2.z));
        w.w = cvt_pk_bf16(w0 * lo_bf(o0.w) + w1 * lo_bf(o1.w) + w2 * lo_bf(o2.w), w0 * hi_bf(o0.w) + w1 * hi_bf(o1.w) + w2 * hi_bf(o2.w));
        *(u32x4*)(OATT + (size_t)tok * 512 + seg * 8) = w;
    }
}

constexpr int QP = 72, VP = 392;
constexpr int ATT_Q = 0, ATT_K = 256 * QP * 2, ATT_V = ATT_K + 384 * QP * 2;
constexpr int ATT_ITEMS = 3072;
struct AttItem { int g, b, hh, r, n, dsh; };
__device__ __forceinline__ AttItem att_decode(int item) {
    AttItem it; it.g = item / 1024; it.b = (item >> 8) & 3; it.hh = (item >> 5) & 7; const int rb = item & 31;
    it.dsh = 2 * it.g; const int nbk = 32 >> it.dsh; it.r = rb / nbk; it.n = 2 * (rb % nbk); return it;
}
__device__ __forceinline__ void att_load(const bf16_t* QKVA, const AttItem& it, int tid, u32x4 (&q)[4], u32x4 (&k)[6], u32x4 (&v)[6]) {
    const size_t SEC = (size_t)3 * 8 * 4 * T * 64;
    const int L = T >> it.dsh;
    const bf16_t* base = QKVA + ((((size_t)(it.g * 8 + it.hh) * 4 + it.b) * T + (size_t)it.r * L) << 6);
#pragma unroll
    for (int i = 0; i < 4; ++i) { const int p = tid + i * NTHR, row = p >> 3, seg = p & 7;
        q[i] = *(const u32x4*)(base + ((size_t)(128 * it.n + row) << 6) + seg * 8); }
#pragma unroll
    for (int i = 0; i < 6; ++i) { const int p = tid + i * NTHR, row = p >> 3, seg = p & 7; const int uu = 128 * (it.n - 1) + row;
        k[i] = (u32x4){0u, 0u, 0u, 0u};
        if (uu >= 0) k[i] = *(const u32x4*)(base + SEC + ((size_t)uu << 6) + seg * 8); }
#pragma unroll
    for (int i = 0; i < 3; ++i) { const int idx = tid + i * NTHR, kp = idx % 192, seg = idx / 192; const int uu = 128 * (it.n - 1) + 2 * kp;
        v[2 * i] = (u32x4){0u, 0u, 0u, 0u}; v[2 * i + 1] = (u32x4){0u, 0u, 0u, 0u};
        if (uu >= 0) { const bf16_t* vp = base + 2 * SEC + ((size_t)uu << 6) + seg * 8;
                       v[2 * i] = *(const u32x4*)vp; v[2 * i + 1] = *(const u32x4*)(vp + 64); } }
}
__device__ __forceinline__ void att_store(LAS bf16_t* Qs, LAS bf16_t* Ks, LAS bf16_t* Vt, int tid, const u32x4 (&q)[4], const u32x4 (&k)[6], const u32x4 (&v)[6]) {
#pragma unroll
    for (int i = 0; i < 4; ++i) { const int p = tid + i * NTHR, row = p >> 3, seg = p & 7; *(LAS u32x4*)(Qs + row * QP + seg * 8) = q[i]; }
#pragma unroll
    for (int i = 0; i < 6; ++i) { const int p = tid + i * NTHR, row = p >> 3, seg = p & 7; *(LAS u32x4*)(Ks + row * QP + seg * 8) = k[i]; }
#pragma unroll
    for (int i = 0; i < 3; ++i) { const int idx = tid + i * NTHR, kp = idx % 192, seg = idx / 192;
        const int k0 = 2 * kp, vpos = (k0 & ~31) + 8 * ((k0 >> 2) & 3) + 4 * ((k0 >> 4) & 1) + (k0 & 3);
        LAS unsigned* vd = (LAS unsigned*)(Vt + (seg * 8) * VP + vpos);
        const u32x4 a = v[2 * i], b2 = v[2 * i + 1];
        vd[0 * (VP / 2)] = (a.x & 0xffffu) | (b2.x << 16); vd[1 * (VP / 2)] = (a.x >> 16) | (b2.x & 0xffff0000u);
        vd[2 * (VP / 2)] = (a.y & 0xffffu) | (b2.y << 16); vd[3 * (VP / 2)] = (a.y >> 16) | (b2.y & 0xffff0000u);
        vd[4 * (VP / 2)] = (a.z & 0xffffu) | (b2.z << 16); vd[5 * (VP / 2)] = (a.z >> 16) | (b2.z & 0xffff0000u);
        vd[6 * (VP / 2)] = (a.w & 0xffffu) | (b2.w << 16); vd[7 * (VP / 2)] = (a.w >> 16) | (b2.w & 0xffff0000u); }
}
__device__ __forceinline__ void p3_attention(const Args& a, LAS unsigned char* lds) {
    const int tid = threadIdx.x, lane = tid & 63, w = tid >> 6, l15 = lane & 15, q4 = lane >> 4;
    const bf16_t* QKVA = (const bf16_t*)(a.ws + WS_QKVA);
    bf16_t* OG = (bf16_t*)((unsigned char*)a.out + OUT_OG); float* LSE = (float*)((unsigned char*)a.out + OUT_LSE);
    LAS bf16_t* Qs = (LAS bf16_t*)(lds + ATT_Q); LAS bf16_t* Ks = (LAS bf16_t*)(lds + ATT_K); LAS bf16_t* Vt = (LAS bf16_t*)(lds + ATT_V);
    const int G = gridDim.x, bx = blockIdx.x;
    const int vcu = (G % 8 == 0) ? (bx % 8) * (G / 8) + bx / 8 : bx;
    u32x4 rq[4], rk[6], rv[6];
    int item = vcu;
    if (item < ATT_ITEMS) { const AttItem it = att_decode(item); att_load(QKVA, it, tid, rq, rk, rv); }
    __syncthreads();
    if (item < ATT_ITEMS) att_store(Qs, Ks, Vt, tid, rq, rk, rv);
    __syncthreads();
    for (; item < ATT_ITEMS; item += G) {
        const AttItem it = att_decode(item);
        const int g = it.g, b = it.b, hh = it.hh, r = it.r, dsh = it.dsh, d = 1 << dsh;
        const int nxt = item + G;
        if (nxt < ATT_ITEMS) { const AttItem itn = att_decode(nxt); att_load(QKVA, itn, tid, rq, rk, rv); }
        const int cb = 32 * (w >> 1);
        const int iq = 16 * w + l15;
#pragma unroll 1
        for (int sb = 0; sb < 2; ++sb) {
        const int n = it.n + sb, qo = 128 * sb, cbs = 128 * sb + cb;
        bf16x8 qf[2];
#pragma unroll
        for (int ks = 0; ks < 2; ++ks) qf[ks] = *(const LAS bf16x8*)(Qs + (qo + iq) * QP + ks * 32 + q4 * 8);
        f32x4 s[10];
        __builtin_amdgcn_s_setprio(1);
#pragma unroll
        for (int i = 0; i < 10; ++i) {
            s[i] = (f32x4){0.f, 0.f, 0.f, 0.f};
#pragma unroll
            for (int ks = 0; ks < 2; ++ks) { const bf16x8 kf = *(const LAS bf16x8*)(Ks + (cbs + 16 * i + l15) * QP + ks * 32 + q4 * 8);
                s[i] = __builtin_amdgcn_mfma_f32_16x16x32_bf16(kf, qf[ks], s[i], 0, 0, 0); }
        }
        __builtin_amdgcn_s_setprio(0);
        const int sidx = 8 * g + hh;
        const float nslope = -1.4426950408889634f * exp2f(sidx < 16 ? -0.25f * (float)(sidx + 1) : -4.0f - 0.5f * (float)(sidx - 15)) * (float)d;
        const float basef = (float)(iq - cb - 4 * q4 + 128);
        const float dhi = (n > 0) ? 128.0f : fminf(128.0f, (float)iq);
        float mx = -1e30f;
#pragma unroll
        for (int i = 0; i < 10; ++i)
#pragma unroll
            for (int j = 0; j < 4; ++j) { const float dl = basef - (float)(16 * i + j);
                const bool valid = __builtin_fmaxf(__builtin_fminf(dl, dhi), 0.0f) == dl;
                const float v = valid ? __builtin_fmaf(nslope, dl, s[i][j]) : -1e30f; s[i][j] = v; mx = fmaxf(mx, v); }
        { const int xi = __float_as_int(mx); const auto r16 = __builtin_amdgcn_permlane16_swap(xi, xi, false, false); mx = fmaxf(__int_as_float(r16[0]), __int_as_float(r16[1]));
          const int yi = __float_as_int(mx); const auto r32 = __builtin_amdgcn_permlane32_swap(yi, yi, false, false); mx = fmaxf(__int_as_float(r32[0]), __int_as_float(r32[1])); }
        float den = 0.f;
#pragma unroll
        for (int i = 0; i < 10; ++i)
#pragma unroll
            for (int j = 0; j < 4; ++j) { const float p = __builtin_amdgcn_exp2f(s[i][j] - mx); s[i][j] = p; den += p; }
        { const int xi = __float_as_int(den); const auto r16 = __builtin_amdgcn_permlane16_swap(xi, xi, false, false); den = __int_as_float(r16[0]) + __int_as_float(r16[1]);
          const int yi = __float_as_int(den); const auto r32 = __builtin_amdgcn_permlane32_swap(yi, yi, false, false); den = __int_as_float(r32[0]) + __int_as_float(r32[1]); }
        f32x4 o[4];
#pragma unroll
        for (int dt = 0; dt < 4; ++dt) o[dt] = (f32x4){0.f, 0.f, 0.f, 0.f};
        __builtin_amdgcn_s_setprio(1);
#pragma unroll
        for (int c = 0; c < 5; ++c) {
            u32x4 pw; pw.x = cvt_pk_bf16(s[2 * c][0], s[2 * c][1]); pw.y = cvt_pk_bf16(s[2 * c][2], s[2 * c][3]); pw.z = cvt_pk_bf16(s[2 * c + 1][0], s[2 * c + 1][1]); pw.w = cvt_pk_bf16(s[2 * c + 1][2], s[2 * c + 1][3]);
            const bf16x8 pf = __builtin_bit_cast(bf16x8, pw);
#pragma unroll
            for (int dt = 0; dt < 4; ++dt) {
                const bf16x8 vf = *(const LAS bf16x8*)(Vt + (dt * 16 + l15) * VP + cbs + 32 * c + 8 * q4);
                o[dt] = __builtin_amdgcn_mfma_f32_16x16x32_bf16(vf, pf, o[dt], 0, 0, 0);
            }
        }
        __builtin_amdgcn_s_setprio(0);
        const float inv = __builtin_amdgcn_rcpf(den);
        const size_t tok = (size_t)b * T + (((128 * n + iq) << dsh) + r);
        bf16_t* op = OG + (size_t)g * M * 512 + tok * 512 + hh * 64 + q4 * 4;
#pragma unroll
        for (int dt = 0; dt < 4; ++dt) { u32x2 ww; ww.x = cvt_pk_bf16(o[dt][0] * inv, o[dt][1] * inv); ww.y = cvt_pk_bf16(o[dt][2] * inv, o[dt][3] * inv); *(u32x2*)(op + dt * 16) = ww; }
        if (q4 == 0) LSE[(size_t)g * M * 8 + tok * 8 + hh] = (mx + __builtin_amdgcn_logf(den)) * 0.6931471805599453f;
        }
        __syncthreads();
        if (nxt < ATT_ITEMS) att_store(Qs, Ks, Vt, tid, rq, rk, rv);
        __syncthreads();
    }
}

constexpr int TC = 32, SPITCH = 392;
typedef float f32x2 __attribute__((ext_vector_type(2)));
template <int CTRL> __device__ __forceinline__ float dpp_f(float x) { return __int_as_float(__builtin_amdgcn_update_dpp(0, __float_as_int(x), CTRL, 0xf, 0xf, false)); }
struct ScanRegs { u32x2 pr, pk, pv, qr, qk, qv, wl, as; };
__device__ __forceinline__ void scan_issue(ScanRegs& R, const bf16_t* PRKV, const unsigned short* WLOG, const bf16_t* ASIG, size_t tok, int ch, int want_prev) {
    const bf16_t* pp = PRKV + tok * 3072 + ch;
    R.pr = *(const u32x2*)pp; R.pk = *(const u32x2*)(pp + 1024); R.pv = *(const u32x2*)(pp + 2048);
    R.qr = (u32x2){0u, 0u}; R.qk = (u32x2){0u, 0u}; R.qv = (u32x2){0u, 0u};
    if (want_prev == 1) { R.qr = *(const u32x2*)(pp - 3072); R.qk = *(const u32x2*)(pp - 3072 + 1024); R.qv = *(const u32x2*)(pp - 3072 + 2048); }
    R.wl = *(const u32x2*)(WLOG + tok * 1024 + ch); R.as = *(const u32x2*)(ASIG + tok * 1024 + ch);
}
__device__ __forceinline__ void unpack4(const u32x2 u, float (&f)[4]) { f[0] = lo_bf(u.x); f[1] = hi_bf(u.x); f[2] = lo_bf(u.y); f[3] = hi_bf(u.y); }
__device__ __forceinline__ float scan_prepare(const ScanRegs& R, const u32x2 qr_, const u32x2 qk_, const u32x2 qv_, LAS float* slot, int cq, const f32x4 mur, const f32x4 muk, const f32x4 muv, const f32x4 kkc, const f32x4 kac, const f32x4 rkc) {
    float pr[4], pk[4], pv[4], qr[4], qk[4], qv[4], av[4], om[4];
    unpack4(R.pr, pr); unpack4(R.pk, pk); unpack4(R.pv, pv); unpack4(qr_, qr); unpack4(qk_, qk); unpack4(qv_, qv); unpack4(R.as, av);
    om[0] = f16_to_f((unsigned short)(R.wl.x & 0xffffu)); om[1] = f16_to_f((unsigned short)(R.wl.x >> 16)); om[2] = f16_to_f((unsigned short)(R.wl.y & 0xffffu)); om[3] = f16_to_f((unsigned short)(R.wl.y >> 16));
    float rr[4], vv[4], kn[4], k2[4], dec[4], bu[4];
    float ssq = 0.f, bon = 0.f, c1 = 0.f, c2 = 0.f;
#pragma unroll
    for (int j = 0; j < 4; ++j) {
        rr[j] = pr[j] + (qr[j] - pr[j]) * mur[j]; const float kk0 = pk[j] + (qk[j] - pk[j]) * muk[j]; vv[j] = pv[j] + (qv[j] - pv[j]) * muv[j];
        dec[j] = 1.0f - om[j];
        kn[j] = kk0 * kkc[j]; ssq += kn[j] * kn[j];
        k2[j] = kk0 * (1.0f + (av[j] - 1.0f) * kac[j]);
        const float t = rr[j] * k2[j]; bon += t * rkc[j]; c2 += t;
        bu[j] = kn[j] * av[j]; c1 += bu[j] * rr[j];
    }
    ssq += dpp_f<0x121>(ssq); bon += dpp_f<0x121>(bon); c1 += dpp_f<0x121>(c1); c2 += dpp_f<0x121>(c2);
    ssq += dpp_f<0x122>(ssq); bon += dpp_f<0x122>(bon); c1 += dpp_f<0x122>(c1); c2 += dpp_f<0x122>(c2);
    ssq += dpp_f<0x124>(ssq); bon += dpp_f<0x124>(bon); c1 += dpp_f<0x124>(c1); c2 += dpp_f<0x124>(c2);
    ssq += dpp_f<0x128>(ssq); bon += dpp_f<0x128>(bon); c1 += dpp_f<0x128>(c1); c2 += dpp_f<0x128>(c2);
    const float inv = __builtin_amdgcn_rsqf(fmaxf(ssq, 1e-24f));
    f32x4 o_al, o_be, o_wr;
#pragma unroll
    for (int j = 0; j < 4; ++j) { o_al[j] = -(kn[j] * inv); o_be[j] = bu[j] * inv; o_wr[j] = dec[j] * rr[j]; }
    LAS f32x4* s4 = (LAS f32x4*)slot;
    s4[cq] = (f32x4){dec[0], dec[1], dec[2], dec[3]}; s4[16 + cq] = (f32x4){k2[0], k2[1], k2[2], k2[3]}; s4[32 + cq] = o_al; s4[48 + cq] = o_be; s4[64 + cq] = o_wr;
    s4[80 + cq] = (f32x4){vv[0], vv[1], vv[2], vv[3]};
    if (cq == 0) *(LAS f32x2*)(slot + 384) = (f32x2){c1 * inv, c2};
    return bon;
}
__device__ __forceinline__ float ysum4(const LAS float* p) { const f32x4 a = *(const LAS f32x4*)p; return (a[0] + a[1]) + (a[2] + a[3]); }
struct ScanOps { f32x4 wv, kv, al, be, wr; f32x2 cc; float vi; };
__device__ __forceinline__ void scan_ld(ScanOps& o, const LAS float* sl, int jq4, int myrow) {
    o.al = *(const LAS f32x4*)(sl + 128 + jq4); o.wr = *(const LAS f32x4*)(sl + 256 + jq4); o.vi = sl[320 + myrow]; o.kv = *(const LAS f32x4*)(sl + 64 + jq4);
    o.be = *(const LAS f32x4*)(sl + 192 + jq4); o.wv = *(const LAS f32x4*)(sl + jq4); o.cc = *(const LAS f32x2*)(sl + 384);
}
__device__ __forceinline__ void p8_scan(const Args& a, LAS unsigned char* lds) {
    const int tid = threadIdx.x, lane = tid & 63, w = __builtin_amdgcn_readfirstlane(tid >> 6);
    const bf16_t* PRKV = (const bf16_t*)(a.ws + WS_PRKV); const unsigned short* WLOG = (const unsigned short*)(a.ws + WS_WLOG);
    const bf16_t* ASIG = (const bf16_t*)((const unsigned char*)a.out + OUT_ASIG);
    bf16_t* Y = (bf16_t*)(a.ws + WS_Y); float* BONUS = (float*)(a.ws + WS_BONUS);
    const float* mu_rkv = a.in[9]; const float* k_k = a.in[19]; const float* k_a = a.in[20]; const float* r_k = a.in[21];
    LAS float* buf = (LAS float*)lds;
    LAS float* ybuf = (LAS float*)(lds + 2 * TC * SPITCH * 4);
    LAS float* dump = ybuf + 2 * TC * 64;
    const int p = tid & 255, ltt = p >> 4, cq = p & 15;
    const int jq4 = 4 * (lane & 15);
    for (int item = blockIdx.x; item < 256; item += gridDim.x) {
        const int bh = item & 63, rq = item >> 6, b = bh >> 4, h = bh & 15;
        const int ch = h * 64 + 4 * cq;
        const int myrow = 16 * rq + 4 * (w & 3) + (lane >> 4);
        __syncthreads();
        if (w >= 4) {
            const f32x4 mur = *(const f32x4*)(mu_rkv + ch), muk = *(const f32x4*)(mu_rkv + 1024 + ch), muv = *(const f32x4*)(mu_rkv + 2048 + ch),
                        kkc = *(const f32x4*)(k_k + ch), kac = *(const f32x4*)(k_a + ch), rkc = *(const f32x4*)(r_k + ch);
            ScanRegs A0, A1, B0, B1;
            { const size_t tok = (size_t)b * T + 2 * ltt; scan_issue(A0, PRKV, WLOG, ASIG, tok, ch, ltt > 0 ? 1 : 2); scan_issue(A1, PRKV, WLOG, ASIG, tok + 1, ch, 0);
              const float b0 = scan_prepare(A0, A0.qr, A0.qk, A0.qv, buf + (2 * ltt) * SPITCH, cq, mur, muk, muv, kkc, kac, rkc);
              const float b1 = scan_prepare(A1, A0.pr, A0.pk, A0.pv, buf + (2 * ltt + 1) * SPITCH, cq, mur, muk, muv, kkc, kac, rkc);
              if (rq == 0 && cq == 0) { BONUS[tok * 16 + h] = b0; BONUS[(tok + 1) * 16 + h] = b1; }
              scan_issue(A0, PRKV, WLOG, ASIG, tok + TC, ch, 1); scan_issue(A1, PRKV, WLOG, ASIG, tok + TC + 1, ch, 0);
              scan_issue(B0, PRKV, WLOG, ASIG, tok + 2 * TC, ch, 1); scan_issue(B1, PRKV, WLOG, ASIG, tok + 2 * TC + 1, ch, 0); }
            __syncthreads();
#define PROD_STEP(c, X0, X1) do { \
                const int cur = (c) & 1; \
                const size_t tokn = (size_t)b * T + ((c) + 1) * TC + 2 * ltt; \
                if ((c) > 0) { const LAS float* yb = ybuf + (cur ^ 1) * TC * 64; bf16_t* yd = Y + ((size_t)b * T + ((c) - 1) * TC + 2 * ltt) * 1024 + h * 64 + 16 * rq + cq; \
                               yd[0] = f2bf(ysum4(yb + (2 * ltt) * 64 + cq * 4)); yd[1024] = f2bf(ysum4(yb + (2 * ltt + 1) * 64 + cq * 4)); } \
                if ((c) + 1 < T / TC) { \
                    LAS float* nb = buf + (cur ^ 1) * TC * SPITCH; \
                    const float b0 = scan_prepare(X0, X0.qr, X0.qk, X0.qv, nb + (2 * ltt) * SPITCH, cq, mur, muk, muv, kkc, kac, rkc); \
                    const float b1 = scan_prepare(X1, X0.pr, X0.pk, X0.pv, nb + (2 * ltt + 1) * SPITCH, cq, mur, muk, muv, kkc, kac, rkc); \
                    if (rq == 0 && cq == 0) { BONUS[tokn * 16 + h] = b0; BONUS[(tokn + 1) * 16 + h] = b1; } \
                    if ((c) + 3 < T / TC) { scan_issue(X0, PRKV, WLOG, ASIG, tokn + 2 * TC, ch, 1); scan_issue(X1, PRKV, WLOG, ASIG, tokn + 2 * TC + 1, ch, 0); } \
                } \
                __syncthreads(); } while (0)
            for (int c = 0; c < T / TC; c += 2) { PROD_STEP(c, A0, A1); PROD_STEP(c + 1, B0, B1); }
#undef PROD_STEP
            { const LAS float* yb = ybuf + 1 * TC * 64; bf16_t* yd = Y + ((size_t)b * T + (T / TC - 1) * TC + 2 * ltt) * 1024 + h * 64 + 16 * rq + cq;
              yd[0] = f2bf(ysum4(yb + (2 * ltt) * 64 + cq * 4)); yd[1024] = f2bf(ysum4(yb + (2 * ltt + 1) * 64 + cq * 4)); }
        } else {
            f32x2 S01 = (f32x2){0.f, 0.f}, S23 = (f32x2){0.f, 0.f};
            const bool holds_y = (lane & 3) == 0;
            const float m0 = (lane & 15) == 0 ? 1.0f : 0.0f;
            __syncthreads();
            for (int c = 0; c < T / TC; ++c) {
                const int cur = c & 1;
                const LAS float* bt = buf + cur * TC * SPITCH;
                LAS float* yd = holds_y ? (ybuf + cur * TC * 64 + 4 * (4 * w + (lane >> 4)) + ((lane & 15) >> 2)) : (dump + lane);
                ScanOps o; scan_ld(o, bt, jq4, myrow);
#pragma unroll 8
                for (int tt = 0; tt < TC; ++tt) {
                    ScanOps n; scan_ld(n, bt + (tt + 1 < TC ? tt + 1 : tt) * SPITCH, jq4, myrow);
                    __builtin_amdgcn_sched_barrier(0);
                    f32x2 ta = S01 * o.al.lo, ty = S01 * o.wr.lo; ta = S23 * o.al.hi + ta; ty = S23 * o.wr.hi + ty;
                    float pa = ta.x + ta.y, py = ty.x + ty.y;
                    f32x2 kv01 = o.kv.lo * o.vi, kv23 = o.kv.hi * o.vi;
                    float vc = o.vi * o.cc.y;
                    asm volatile("" : "+v"(kv01), "+v"(kv23), "+v"(vc));
                    pa += dpp_f<0x121>(pa); py += dpp_f<0x121>(py); pa += dpp_f<0x122>(pa); py += dpp_f<0x122>(py);
                    pa += dpp_f<0x124>(pa); pa += dpp_f<0x128>(pa);
                    S01 = S01 * o.wv.lo + (o.be.lo * pa + kv01);
                    S23 = S23 * o.wv.hi + (o.be.hi * pa + kv23);
                    yd[tt * 64] = (pa * o.cc.x + vc) * m0 + py;
                    __builtin_amdgcn_sched_barrier(0);
                    o = n;
                }
                __syncthreads();
            }
        }
    }
}
struct P8bRow { u32x4 y0, y1, v0, v1, g0, g1; float bon; };
__device__ __forceinline__ void p8b_load(P8bRow& r, const bf16_t* Y, const bf16_t* PRKV, const bf16_t* GG, const float* BONUS, int row, int c0, int lane) {
    r.y0 = *(const u32x4*)(Y + (size_t)row * 1024 + c0); r.y1 = *(const u32x4*)(Y + (size_t)row * 1024 + c0 + 8);
    r.v0 = *(const u32x4*)(PRKV + (size_t)row * 3072 + 2048 + c0); r.v1 = *(const u32x4*)(PRKV + (size_t)row * 3072 + 2048 + c0 + 8);
    r.g0 = *(const u32x4*)(GG + (size_t)row * 1024 + c0); r.g1 = *(const u32x4*)(GG + (size_t)row * 1024 + c0 + 8);
    r.bon = BONUS[(size_t)row * 16 + (lane >> 2)];
}
__device__ __forceinline__ void unpack8(const u32x4 u, float (&f)[8]) { f[0] = lo_bf(u.x); f[1] = hi_bf(u.x); f[2] = lo_bf(u.y); f[3] = hi_bf(u.y); f[4] = lo_bf(u.z); f[5] = hi_bf(u.z); f[6] = lo_bf(u.w); f[7] = hi_bf(u.w); }
__device__ __forceinline__ void p8b_post(const Args& a) {
    const int lane = threadIdx.x & 63, wave = threadIdx.x >> 6;
    const bf16_t* PRKV = (const bf16_t*)(a.ws + WS_PRKV); bf16_t* Y = (bf16_t*)(a.ws + WS_Y); const float* BONUS = (const float*)(a.ws + WS_BONUS);
    const bf16_t* GG = (const bf16_t*)((const unsigned char*)a.out + OUT_GG);
    const float* muv = a.in[9] + 2048; const float* lnw = a.in[22]; const float* lnb = a.in[23];
    const int c0 = lane * 16;
    f32x4 mu[4], lw[4], lb[4];
#pragma unroll
    for (int i = 0; i < 4; ++i) { mu[i] = *(const f32x4*)(muv + c0 + 4 * i); lw[i] = *(const f32x4*)(lnw + c0 + 4 * i); lb[i] = *(const f32x4*)(lnb + c0 + 4 * i); }
    for (int base = (blockIdx.x * 8 + wave) * RPW; base < M; base += gridDim.x * 8 * RPW) {
        u32x4 p0 = (u32x4){0u, 0u, 0u, 0u}, p1 = (u32x4){0u, 0u, 0u, 0u};
        if ((base & (T - 1)) != 0) { p0 = *(const u32x4*)(PRKV + (size_t)(base - 1) * 3072 + 2048 + c0); p1 = *(const u32x4*)(PRKV + (size_t)(base - 1) * 3072 + 2048 + c0 + 8); }
        P8bRow r; p8b_load(r, Y, PRKV, GG, BONUS, base, c0, lane);
#pragma unroll 2
        for (int k = 0; k < RPW; ++k) {
            const int row = base + k, rn = (k + 1 < RPW) ? row + 1 : row;
            P8bRow n; p8b_load(n, Y, PRKV, GG, BONUS, rn, c0, lane);
            float y[16];
            { float t0[8], t1[8]; unpack8(r.y0, t0); unpack8(r.y1, t1);
#pragma unroll
              for (int j = 0; j < 8; ++j) { y[j] = t0[j]; y[8 + j] = t1[j]; } }
            float s = 0.f;
#pragma unroll
            for (int j = 0; j < 16; ++j) s += y[j];
            s += __shfl_xor(s, 1); s += __shfl_xor(s, 2);
            const float mean = s * (1.0f / 64.0f);
            float q = 0.f;
#pragma unroll
            for (int j = 0; j < 16; ++j) { y[j] -= mean; q += y[j] * y[j]; }
            q += __shfl_xor(q, 1); q += __shfl_xor(q, 2);
            const float rstd = rsqrtf(q * (1.0f / 64.0f) + 64e-5f);
#pragma unroll
            for (int hf = 0; hf < 2; ++hf) {
                float cur[8], prv[8], gv[8];
                unpack8(hf ? r.v1 : r.v0, cur); unpack8(hf ? p1 : p0, prv); unpack8(hf ? r.g1 : r.g0, gv);
                float o[8];
#pragma unroll
                for (int j = 0; j < 8; ++j) { const int jj = hf * 8 + j; const float v = cur[j] + (prv[j] - cur[j]) * mu[jj >> 2][jj & 3];
                                              o[j] = ((y[jj] * rstd) * lw[jj >> 2][jj & 3] + lb[jj >> 2][jj & 3] + r.bon * v) * gv[j]; }
                u32x4 wv; wv.x = cvt_pk_bf16(o[0], o[1]); wv.y = cvt_pk_bf16(o[2], o[3]); wv.z = cvt_pk_bf16(o[4], o[5]); wv.w = cvt_pk_bf16(o[6], o[7]);
                *(u32x4*)(Y + (size_t)row * 1024 + c0 + hf * 8) = wv;
            }
            p0 = r.v0; p1 = r.v1; r = n;
        }
    }
}

__global__ void __launch_bounds__(NTHR, 2) mega(Args a) {
    extern __shared__ __attribute__((aligned(16))) unsigned char lds_raw[];
    LAS unsigned char* lds = (LAS unsigned char*)lds_raw;
    cg::grid_group grid = cg::this_grid();
    unsigned char* ws = a.ws;
    volatile LAS unsigned* bst = (volatile LAS unsigned*)(lds + LDS_BYTES - 16);
    if (threadIdx.x == 0) { bst[0] = 0u; bst[1] = 0u; }
    __syncthreads();
    XcdBarrier bar = xcd_barrier_post((unsigned*)(ws + WS_BAR), bst);
    const int lo = a.ph_lo, hi = a.ph_hi;
#ifndef PHMASK
#define PHMASK 0x3ffff
#endif
#define IN(k) (((PHMASK >> (k)) & 1) && lo <= (k) && (k) < hi)
#define SYNC(k) do { if ((k) + 1 < hi) { if (lo < 0) grid.sync(); else xcd_barrier(bar); } } while (0)
    if (IN(0)) { p0_prologue(a, lds); SYNC(0); }
    if (IN(1)) { p1_prenorm(a); SYNC(1); }
    if (IN(2)) { Epi<EP_QKV> E{(bf16_t*)(ws + WS_QKVA), 4608, nullptr, nullptr, nullptr, nullptr, nullptr, nullptr};
                 run_gemm<EP_QKV>(lds, (const bf16_t*)(ws + WS_HB), (const bf16_t*)(ws + WS_WA), 4608, 1024, E); SYNC(2); }
    if (IN(3)) { p3_attention(a, lds); SYNC(3); }
    if (IN(4)) { p4_combine(a); }
    if (IN(5)) { Epi<EP_SPLIT> E{(bf16_t*)(ws + WS_PRKV), 3072, (bf16_t*)(ws + WS_P), nullptr, nullptr, nullptr, nullptr, nullptr};
                 run_gemm<EP_SPLIT>(lds, (const bf16_t*)(ws + WS_HB), (const bf16_t*)(ws + WS_WB), 3840, 1024, E); SYNC(5); }
    if (IN(6)) { p6_loramid(a); SYNC(6); }
    if (IN(7)) { Epi<EP_L2> E{(bf16_t*)(ws + WS_WLOG), 1024, (bf16_t*)((unsigned char*)a.out + OUT_ASIG), (bf16_t*)((unsigned char*)a.out + OUT_GG), nullptr, nullptr, a.in[11], a.in[14]};
                 run_gemm<EP_L2>(lds, (const bf16_t*)(ws + WS_A2), (const bf16_t*)(ws + WS_W2), 3072, 384, E); SYNC(7); }
    if (IN(8)) { p8_scan(a, lds); SYNC(8); }
    if (IN(9)) { p8b_post(a); }
    if (IN(10)) { Epi<EP_SIG> E{(bf16_t*)((unsigned char*)a.out + OUT_ASIG), 1024, (bf16_t*)(ws + WS_WLOG), nullptr, nullptr, nullptr, nullptr, nullptr};
                  run_gemm<EP_SIG>(lds, (const bf16_t*)(ws + WS_HB), (const bf16_t*)(ws + WS_WC), 2048, 1024, E); SYNC(10); }
    if (IN(11)) { Epi<EP_MULG> E{(bf16_t*)(ws + WS_T1), 1024, nullptr, nullptr, (const bf16_t*)((const unsigned char*)a.out + OUT_ASIG), nullptr, nullptr, nullptr};
                  run_gemm<EP_MULG>(lds, (const bf16_t*)(ws + WS_Y), (const bf16_t*)(ws + WS_WOR), 1024, 1024, E); }
    if (IN(12)) { Epi<EP_MIX> E{(bf16_t*)(ws + WS_MIXIN), 1024, nullptr, nullptr, (const bf16_t*)(ws + WS_WLOG), (const bf16_t*)(ws + WS_T1), nullptr, nullptr};
                  run_gemm<EP_MIX>(lds, (const bf16_t*)(ws + WS_OATT), (const bf16_t*)(ws + WS_WOA), 1024, 512, E); SYNC(12); }
    if (IN(13)) { Epi<EP_PLAIN> E{(bf16_t*)(ws + WS_MIXED), 1024, nullptr, nullptr, nullptr, nullptr, nullptr, nullptr};
                  run_gemm<EP_PLAIN>(lds, (const bf16_t*)(ws + WS_MIXIN), (const bf16_t*)(ws + WS_WOUT), 1024, 1024, E); SYNC(13); }
    if (IN(14)) { p13_mid(a); SYNC(14); }
    if (IN(15)) { Epi<EP_SWIGLU> E{(bf16_t*)(ws + WS_U), 2816, nullptr, nullptr, nullptr, nullptr, nullptr, nullptr};
                  run_gemm<EP_SWIGLU>(lds, (const bf16_t*)(ws + WS_HB), (const bf16_t*)(ws + WS_WFI), 5632, 1024, E); SYNC(15); }
    if (IN(16)) { Epi<EP_PLAIN> E{(bf16_t*)(ws + WS_Y2), 1024, nullptr, nullptr, nullptr, nullptr, nullptr, nullptr};
                  run_gemm<EP_PLAIN>(lds, (const bf16_t*)(ws + WS_U), (const bf16_t*)(ws + WS_WFO), 1024, 2816, E); SYNC(16); }
    if (IN(17)) { p16_final(a); }
#undef IN
#undef SYNC
}

#ifndef MK_MULTI
#define MK_MULTI 0
#endif
extern "C" void kernel_launch(void* const* d_in, const int* in_sizes, int n_in, void* d_out, int out_size, void* d_ws, size_t ws_size, hipStream_t stream) {
    static int grid = 0;
    if (grid == 0) {
        if (n_in != 29 || out_size != M * D || ws_size < WS_END) { fprintf(stderr, "kernel_launch: unexpected problem shape (n_in %d out %d ws %zu)\n", n_in, out_size, ws_size); grid = -1; return; }
        int dev = 0, cus = 0, per_cu = 0;
        hipGetDevice(&dev);
        hipDeviceGetAttribute(&cus, hipDeviceAttributeMultiprocessorCount, dev);
        hipFuncSetAttribute((const void*)mega, hipFuncAttributeMaxDynamicSharedMemorySize, LDS_BYTES);
        hipOccupancyMaxActiveBlocksPerMultiprocessor(&per_cu, (const void*)mega, NTHR, LDS_BYTES);
        if (per_cu < 1) per_cu = 1;
        grid = cus * per_cu;
        (void)hipGetLastError();
    }
    if (grid < 0) return;
    Args a{};
    for (int i = 0; i < 29; ++i) a.in[i] = (const float*)d_in[i];
    a.out = (float*)d_out; a.ws = (unsigned char*)d_ws;
#if MK_MULTI
    for (int ph = 0; ph < NPHASE; ++ph) { a.ph_lo = ph; a.ph_hi = ph + 1; hipLaunchKernelGGL(mega, dim3(grid), dim3(NTHR), LDS_BYTES, stream, a); }
#else
    a.ph_lo = 0; a.ph_hi = NPHASE;
    if (hipMemsetAsync((unsigned char*)d_ws + WS_BAR, 0, XCD_BAR_WORDS * 4, stream) != hipSuccess) { fprintf(stderr, "kernel_launch: memset of the barrier words failed\n"); return; }
    void* args[] = {&a};
    hipError_t e = hipLaunchCooperativeKernel((const void*)mega, dim3(grid), dim3(NTHR), args, LDS_BYTES, stream);
    if (e != hipSuccess) fprintf(stderr, "cooperative launch failed: %s (grid %d)\n", hipGetErrorString(e), grid);
#endif
}
```

```cpp
#include <hip/hip_runtime.h>
#include <hip/hip_cooperative_groups.h>
#include <cstdio>
#include <cstdint>
namespace cg = cooperative_groups;
namespace pg8 {
#define PG8_LAS __attribute__((address_space(3)))
typedef unsigned short bf16_t;
typedef short bf16x8 __attribute__((ext_vector_type(8)));
typedef float f32x4 __attribute__((ext_vector_type(4)));
typedef unsigned u32x4 __attribute__((ext_vector_type(4)));
constexpr int BM = 256, BK = 64, HALF = 128, HTB = HALF * BK * 2  , STAGE_BYTES = 8 * HTB, NXCD = 8, WGM = 8;

__host__ __device__ __forceinline__ int lds_byte(int r, int c) { const int st = (r >> 4) * 2 + (c >> 5), rr = r & 15, cc = c & 31, ob = rr * 64 + cc * 2; return st * 1024 + (ob ^ (((ob >> 9) & 1) << 5)); }
__host__ __device__ __forceinline__ void stage_rc(int b, int& R, int& C) { const int st = b / 1024, sb = b % 1024, swz = sb ^ (((sb >> 9) & 1) << 5); R = (st >> 1) * 16 + swz / 64; C = (st & 1) * 32 + (swz % 64) / 2; }
__host__ __device__ __forceinline__ int perm32(int rho) { const int n = rho >> 4, i = rho & 15; return 8 * (i >> 2) + 4 * n + (i & 3); }

struct Unit { int pm, pn; };
struct Gemm { const bf16_t* A; const bf16_t* Bt; int M, N, K; };

struct StaticOrder {
    int nM, nN, nwg, G, c;
    __host__ __device__ void init(int M, int N, int G_, int c_) { nM = M / BM; nN = N / BM; nwg = nM * nN; G = G_; c = c_; }
    __host__ __device__ bool next(int i, Unit& u) const {
        const long L = (long)i * G + c; if (L >= nwg) return false;
        int wgid = (int)L; { const int q = nwg / NXCD, r = nwg % NXCD, xcd = wgid % NXCD, off = wgid / NXCD; wgid = (xcd < r ? xcd * (q + 1) : r * (q + 1) + (xcd - r) * q) + off; }
        const int nig = WGM * nN, gid = wgid / nig, fm = gid * WGM, gsz = (nM - fm) < WGM ? (nM - fm) : WGM;
        u.pm = fm + ((wgid % nig) % gsz); u.pn = (wgid % nig) / gsz; return true;
    }
    __device__ __forceinline__ void a_ready(const Unit&) const {}
    __device__ __forceinline__ void done(const Unit&) const {}
};
__device__ __forceinline__ unsigned cvt_pk_bf16(float lo, float hi) { unsigned r; asm volatile("v_cvt_pk_bf16_f32 %0, %1, %2" : "=v"(r) : "v"(lo), "v"(hi)); return r; }
template <class Epi, class Sched, bool ALIGN_EPI = false, bool SP2 = false>
__device__ __forceinline__ void gemm_phase(PG8_LAS unsigned char* lds, const Gemm g, const Sched& S, const Epi& E) {
    const int tid = threadIdx.x, wid = __builtin_amdgcn_readfirstlane(tid >> 6), lane = tid & 63, wr = wid >> 2, wc = wid & 3, fr = lane & 15, fq = lane >> 4;
    const int K = g.K, nt = K / BK;
    unsigned voffA[2], voffB[2];
#pragma unroll
    for (int i = 0; i < 2; ++i) { int R, C; stage_rc(tid * 16 + i * 8192, R, C); const int Rb = Epi::PERM ? ((R & ~31) + perm32(R & 31)) : R;
        voffA[i] = (unsigned)(R * K + C) * 2u; voffB[i] = (unsigned)(Rb * K + C) * 2u; }
    const size_t kstep = (size_t)(BK * 2);
    const size_t hstep = (size_t)HALF * K * 2;
    const size_t tstep = 2 * hstep;
    const unsigned ldsw = (unsigned)wid * 1024u;
    const int aoff = lds_byte(wr * 64 + fr, fq * 8), boff = lds_byte(wc * 32 + fr, fq * 8);
#define PG8_SA(b, h) (((b) * 2 + (h)) * HTB)
#define PG8_SB(b, h) ((4 + (b) * 2 + (h)) * HTB)
#define PG8_STAGE(bufoff, gbase, voff) do { _Pragma("unroll") for (int _i = 0; _i < 2; ++_i) \
        __builtin_amdgcn_global_load_lds((const unsigned*)((const char*)(gbase) + (voff)[_i]), (PG8_LAS unsigned*)(lds + (bufoff) + ldsw + _i * 8192), 16, 0, 0); } while (0)
#define PG8_LDA(dst, b, h) do { _Pragma("unroll") for (int m = 0; m < 4; ++m) _Pragma("unroll") for (int k = 0; k < 2; ++k) dst[m][k] = *(const PG8_LAS bf16x8*)(lds + PG8_SA(b, h) + aoff + m * 2048 + k * 1024); } while (0)
#define PG8_LDB(dst, b, h) do { _Pragma("unroll") for (int n = 0; n < 2; ++n) _Pragma("unroll") for (int k = 0; k < 2; ++k) dst[n][k] = *(const PG8_LAS bf16x8*)(lds + PG8_SB(b, h) + boff + n * 2048 + k * 1024); } while (0)
#define PG8_MMA(ai, bj, At, Bt) do { __builtin_amdgcn_s_setprio(1); _Pragma("unroll") for (int m = 0; m < 4; ++m) _Pragma("unroll") for (int n = 0; n < 2; ++n) _Pragma("unroll") for (int k = 0; k < 2; ++k) \
        acc[ai][bj][m][n] = __builtin_amdgcn_mfma_f32_16x16x32_bf16(Bt[n][k], At[m][k], acc[ai][bj][m][n], 0, 0, 0); __builtin_amdgcn_s_setprio(0); } while (0)
#define PG8_WAIT_V(n) asm volatile("s_waitcnt vmcnt(" #n ")" ::: "memory")
#define PG8_WAIT_L(n) asm volatile("s_waitcnt lgkmcnt(" #n ")" ::: "memory")
#define PG8_BAR __builtin_amdgcn_s_barrier()
#define PG8_SCHED __builtin_amdgcn_sched_barrier(0)
    Unit cur, nxt; int ui = 0;
    if (!S.next(0, cur)) return;
    f32x4 acc[2][2][4][2];
#pragma unroll
    for (int a = 0; a < 2; ++a)
#pragma unroll
        for (int b = 0; b < 2; ++b)
#pragma unroll
            for (int m = 0; m < 4; ++m)
#pragma unroll
                for (int n = 0; n < 2; ++n) acc[a][b][m][n] = (f32x4){0.f, 0.f, 0.f, 0.f};
    bf16x8 At[4][2], B0[2][2], B1[2][2];
    const char* cA = (const char*)g.A + (size_t)cur.pm * tstep; const char* cB = (const char*)g.Bt + (size_t)cur.pn * tstep;
    S.a_ready(cur);
    if constexpr (SP2) {
        PG8_STAGE(PG8_SB(0, 0), cB, voffB); PG8_STAGE(PG8_SB(0, 1), cB + hstep, voffB); PG8_STAGE(PG8_SA(0, 0), cA, voffA); PG8_STAGE(PG8_SA(0, 1), cA + hstep, voffA);
        if (wr == 1) PG8_BAR;
        PG8_WAIT_V(2); PG8_BAR;
        PG8_STAGE(PG8_SB(1, 0), cB + kstep, voffB); PG8_STAGE(PG8_SA(1, 0), cA + kstep, voffA); PG8_STAGE(PG8_SB(1, 1), cB + hstep + kstep, voffB);
        PG8_WAIT_V(6); PG8_BAR;
    } else {
        PG8_STAGE(PG8_SB(0, 0), cB, voffB); PG8_STAGE(PG8_SA(0, 0), cA, voffA); PG8_STAGE(PG8_SB(0, 1), cB + hstep, voffB); PG8_STAGE(PG8_SA(0, 1), cA + hstep, voffA);
        if (wr == 1) PG8_BAR;
        PG8_WAIT_V(4); PG8_BAR;
        PG8_STAGE(PG8_SB(1, 0), cB + kstep, voffB); PG8_STAGE(PG8_SA(1, 0), cA + kstep, voffA); PG8_STAGE(PG8_SB(1, 1), cB + hstep + kstep, voffB);
        PG8_WAIT_V(6); PG8_BAR;
    }
    for (;;) {
        const bool has_next = S.next(ui + 1, nxt);
        const char* nA = has_next ? (const char*)g.A + (size_t)nxt.pm * tstep : cA; const char* nB = has_next ? (const char*)g.Bt + (size_t)nxt.pn * tstep : cB;
#pragma nounroll
        for (int t = 0; t < nt; t += 2) {
            const bool last = (t == nt - 2);
            const char* a1 = cA + (size_t)(t + 1) * kstep;
            const char* a2 = last ? nA : cA + (size_t)(t + 2) * kstep; const char* b2 = last ? nB : cB + (size_t)(t + 2) * kstep;
            const char* a3 = a2 + kstep; const char* b3 = b2 + kstep;
            if (last && has_next) S.a_ready(nxt);
            if constexpr (SP2) {
            PG8_LDB(B0, 0, 0); PG8_LDB(B1, 0, 1); PG8_SCHED; PG8_LDA(At, 0, 0); PG8_STAGE(PG8_SA(1, 1), a1 + hstep, voffA);
            PG8_WAIT_V(8); PG8_WAIT_L(0); PG8_BAR; PG8_MMA(0, 0, At, B0); PG8_MMA(0, 1, At, B1); PG8_BAR; PG8_SCHED;
            PG8_LDA(At, 0, 1); PG8_STAGE(PG8_SB(0, 0), b2, voffB); PG8_STAGE(PG8_SB(0, 1), b2 + hstep, voffB); PG8_STAGE(PG8_SA(0, 0), a2, voffA);
            PG8_WAIT_V(8); PG8_WAIT_L(0); PG8_BAR; PG8_MMA(1, 0, At, B0); PG8_MMA(1, 1, At, B1); PG8_BAR; PG8_SCHED;
            PG8_LDB(B0, 1, 0); PG8_LDB(B1, 1, 1); PG8_SCHED; PG8_LDA(At, 1, 0); PG8_STAGE(PG8_SA(0, 1), a2 + hstep, voffA);
            PG8_WAIT_V(8); PG8_WAIT_L(0); PG8_BAR; PG8_MMA(0, 0, At, B0); PG8_MMA(0, 1, At, B1); PG8_BAR; PG8_SCHED;
            PG8_LDA(At, 1, 1); PG8_STAGE(PG8_SB(1, 0), b3, voffB); PG8_STAGE(PG8_SB(1, 1), b3 + hstep, voffB); PG8_STAGE(PG8_SA(1, 0), a3, voffA);
            PG8_WAIT_V(8); PG8_WAIT_L(0); PG8_BAR; PG8_MMA(1, 0, At, B0); PG8_MMA(1, 1, At, B1); PG8_BAR; PG8_SCHED;
            } else {
            PG8_LDB(B0, 0, 0); PG8_SCHED; PG8_LDA(At, 0, 0); PG8_STAGE(PG8_SA(1, 1), a1 + hstep, voffA);
            PG8_WAIT_L(8); PG8_BAR; PG8_WAIT_L(0); PG8_MMA(0, 0, At, B0); PG8_BAR; PG8_SCHED;
            PG8_LDB(B1, 0, 1); PG8_STAGE(PG8_SB(0, 0), b2, voffB);
            PG8_BAR; PG8_WAIT_L(0); PG8_MMA(0, 1, At, B1); PG8_BAR;
            PG8_LDA(At, 0, 1); PG8_STAGE(PG8_SA(0, 0), a2, voffA);
            PG8_BAR; PG8_WAIT_L(0); PG8_MMA(1, 0, At, B0); PG8_BAR; PG8_SCHED;
            PG8_STAGE(PG8_SB(0, 1), b2 + hstep, voffB);
            PG8_WAIT_V(6); PG8_BAR; PG8_MMA(1, 1, At, B1); PG8_BAR;
            PG8_LDB(B0, 1, 0); PG8_SCHED; PG8_LDA(At, 1, 0); PG8_STAGE(PG8_SA(0, 1), a2 + hstep, voffA);
            PG8_WAIT_L(8); PG8_BAR; PG8_WAIT_L(0); PG8_MMA(0, 0, At, B0); PG8_BAR; PG8_SCHED;
            PG8_LDB(B1, 1, 1); PG8_STAGE(PG8_SB(1, 0), b3, voffB);
            PG8_BAR; PG8_WAIT_L(0); PG8_MMA(0, 1, At, B1); PG8_BAR;
            PG8_LDA(At, 1, 1); PG8_STAGE(PG8_SA(1, 0), a3, voffA);
            PG8_BAR; PG8_WAIT_L(0); PG8_MMA(1, 0, At, B0); PG8_BAR; PG8_SCHED;
            PG8_STAGE(PG8_SB(1, 1), b3 + hstep, voffB);
            PG8_WAIT_V(6); PG8_BAR; PG8_MMA(1, 1, At, B1); PG8_BAR;
            }
        }
        if constexpr (ALIGN_EPI) { if (wr == 0) PG8_BAR; }
        if constexpr (!Epi::AFTER_DRAIN) { E(acc, cur, wr, wc, fr, fq); S.done(cur); }
        if (!has_next) break;
#pragma unroll
        for (int a = 0; a < 2; ++a)
#pragma unroll
            for (int b = 0; b < 2; ++b)
#pragma unroll
                for (int m = 0; m < 4; ++m)
#pragma unroll
                    for (int n = 0; n < 2; ++n) acc[a][b][m][n] = (f32x4){0.f, 0.f, 0.f, 0.f};
        cur = nxt; cA = nA; cB = nB; ++ui;
        if constexpr (ALIGN_EPI) { if (wr == 1) PG8_BAR; }
    }
    PG8_WAIT_V(0);
    if constexpr (!ALIGN_EPI) { if (wr == 0) PG8_BAR; }
    PG8_BAR;
    if constexpr (Epi::AFTER_DRAIN) { E.fused(acc, cur, wr, wc, fr, fq, lds, wid, lane); S.done(cur); }
#undef PG8_SA
#undef PG8_SB
#undef PG8_STAGE
#undef PG8_LDA
#undef PG8_LDB
#undef PG8_MMA
#undef PG8_WAIT_V
#undef PG8_WAIT_L
#undef PG8_BAR
#undef PG8_SCHED
}
}

typedef unsigned short bf16_t;
using pg8::f32x4; using pg8::bf16x8; using pg8::u32x4; using pg8::cvt_pk_bf16;
typedef short s16x4 __attribute__((ext_vector_type(4)));
typedef unsigned u32x2 __attribute__((ext_vector_type(2)));
#define LAS __attribute__((address_space(3)))
constexpr int NB = 4, T = 8192, D = 1024, M = NB * T, NTHR = 512;
constexpr size_t MiB = 1u << 20;
constexpr size_t WS_MOD = 0, WS_BAR = 512 * 1024, WS_BONUS = 1 * MiB, WS_WA = 3 * MiB, WS_WB = 12 * MiB, WS_WC = 20 * MiB, WS_W2 = 24 * MiB, WS_WOR = 27 * MiB, WS_WOA = 29 * MiB,
                 WS_WOUT = 30 * MiB, WS_WFI = 32 * MiB, WS_WFO = 43 * MiB;
constexpr size_t WS_HB = 50 * MiB, WS_QKVA = 114 * MiB, WS_OATT = 442 * MiB;
constexpr size_t WS_PRKV = 114 * MiB, WS_P = 306 * MiB, WS_A2 = 354 * MiB, WS_WLOG = 378 * MiB, WS_Y = 306 * MiB;
constexpr size_t WS_T1 = 242 * MiB, WS_MIXIN = 114 * MiB, WS_MIXED = 378 * MiB;
constexpr size_t WS_U = 114 * MiB, WS_Y2 = 290 * MiB, WS_END = 512 * MiB;
constexpr size_t OUT_OG = 0, OUT_LSE = 96 * MiB, OUT_ASIG = 0, OUT_GG = 64 * MiB;
constexpr int LDS_BYTES = 147456;
constexpr int NPHASE = 18;

struct Args { const float* in[29]; float* out; unsigned char* ws; int ph_lo, ph_hi; };

__device__ __forceinline__ float bf2f(bf16_t v) { return __uint_as_float(((unsigned)v) << 16); }
__device__ __forceinline__ bf16_t f2bf(float f) { unsigned u = __float_as_uint(f); u += 0x7FFFu + ((u >> 16) & 1u); return (bf16_t)(u >> 16); }
__device__ __forceinline__ float lo_bf(unsigned u) { return __uint_as_float(u << 16); }
__device__ __forceinline__ float hi_bf(unsigned u) { return __uint_as_float(u & 0xffff0000u); }
__device__ __forceinline__ float sigmoidf_(float x) { return __builtin_amdgcn_rcpf(1.0f + __expf(-x)); }
__device__ __forceinline__ float wave_sum(float v) {
#pragma unroll
    for (int o = 32; o >= 1; o >>= 1) v += __shfl_xor(v, o);
    return v;
}
__device__ __forceinline__ unsigned pk_f16(float a, float b) {
    const _Float16 ha = (_Float16)a, hb = (_Float16)b;
    return (unsigned)__builtin_bit_cast(unsigned short, ha) | ((unsigned)__builtin_bit_cast(unsigned short, hb) << 16);
}
__device__ __forceinline__ float f16_to_f(unsigned short h) { return (float)__builtin_bit_cast(_Float16, h); }

enum { EP_PLAIN = 0, EP_SPLIT = 1, EP_L2W = 2, EP_SIG = 3, EP_MULG = 4, EP_MIX = 5, EP_SWIGLU = 6, EP_L2A = 7, EP_L2 = 8, EP_QKV = 9 };
template <int MODE> struct Epi {
    static constexpr bool PERM = true, AFTER_DRAIN = false;
    bf16_t* O; int ldc; bf16_t* O2; bf16_t* O3; const bf16_t* G; const bf16_t* G2; const float* v0; const float* v1;
    __device__ __forceinline__ void operator()(const f32x4 (&acc)[2][2][4][2], const pg8::Unit& u, int wr, int wc, int fr, int fq) const {
        const int row0 = u.pm * 256 + wr * 64 + fr, cin = wc * 32 + 8 * fq;
#pragma unroll
        for (int ai = 0; ai < 2; ++ai)
#pragma unroll
            for (int m = 0; m < 4; ++m) {
                const size_t row = (size_t)(row0 + ai * 128 + m * 16);
                if constexpr (MODE == EP_SWIGLU) {
                    const f32x4 g0 = acc[ai][0][m][0], g1 = acc[ai][0][m][1], u0 = acc[ai][1][m][0], u1 = acc[ai][1][m][1];
                    float r[8];
#pragma unroll
                    for (int j = 0; j < 4; ++j) { r[j] = g0[j] * sigmoidf_(g0[j]) * u0[j]; r[4 + j] = g1[j] * sigmoidf_(g1[j]) * u1[j]; }
                    u32x4 w; w.x = cvt_pk_bf16(r[0], r[1]); w.y = cvt_pk_bf16(r[2], r[3]); w.z = cvt_pk_bf16(r[4], r[5]); w.w = cvt_pk_bf16(r[6], r[7]);
                    *(u32x4*)(O + row * ldc + u.pn * 128 + cin) = w;
                } else {
#pragma unroll
                    for (int bj = 0; bj < 2; ++bj) {
                        const int col = u.pn * 256 + bj * 128 + cin;
                        const f32x4 a0 = acc[ai][bj][m][0], a1 = acc[ai][bj][m][1];
                        float r[8] = {a0[0], a0[1], a0[2], a0[3], a1[0], a1[1], a1[2], a1[3]};
                        bf16_t* dst = O + row * ldc + col;
                        if constexpr (MODE == EP_SPLIT) { if (col >= 3072) dst = O2 + row * 768 + (col - 3072); }
                        if constexpr (MODE == EP_QKV) {
                            const int sg = u.pn >> 1, g = sg % 3, hh = (u.pn & 1) * 4 + ((bj * 128 + cin) >> 6), dd = cin & 63;
                            const int bb = (int)(row >> 13), t = (int)row & (T - 1), dsh = 2 * g, r = t & ((1 << dsh) - 1), uu = t >> dsh;
                            dst = O + ((((size_t)(sg * 8 + hh) * 4 + bb) * T + (size_t)r * (T >> dsh) + uu) << 6) + dd;
                        }
                        if constexpr (MODE == EP_SIG) {
#pragma unroll
                            for (int j = 0; j < 8; ++j) r[j] = sigmoidf_(r[j]);
                            dst = (col < 1024) ? (O + row * 1024 + col) : (O2 + row * 1024 + (col - 1024));
                        }
                        if constexpr (MODE == EP_MULG) {
                            const u32x4 gv = *(const u32x4*)(G + row * 1024 + col);
                            r[0] *= lo_bf(gv.x); r[1] *= hi_bf(gv.x); r[2] *= lo_bf(gv.y); r[3] *= hi_bf(gv.y); r[4] *= lo_bf(gv.z); r[5] *= hi_bf(gv.z); r[6] *= lo_bf(gv.w); r[7] *= hi_bf(gv.w);
                        }
                        if constexpr (MODE == EP_MIX) {
                            const u32x4 gv = *(const u32x4*)(G + row * 1024 + col);
                            const u32x4 tv = *(const u32x4*)(G2 + row * 1024 + col);
                            r[0] = lo_bf(tv.x) + r[0] * lo_bf(gv.x); r[1] = hi_bf(tv.x) + r[1] * hi_bf(gv.x); r[2] = lo_bf(tv.y) + r[2] * lo_bf(gv.y); r[3] = hi_bf(tv.y) + r[3] * hi_bf(gv.y);
                            r[4] = lo_bf(tv.z) + r[4] * lo_bf(gv.z); r[5] = hi_bf(tv.z) + r[5] * hi_bf(gv.z); r[6] = lo_bf(tv.w) + r[6] * lo_bf(gv.w); r[7] = hi_bf(tv.w) + r[7] * hi_bf(gv.w);
                        }
                        if constexpr (MODE == EP_L2) {
                            const int region = u.pn >> 2, cc = col - 1024 * region;
                            if (region == 0) {
                                const f32x4 b0 = *(const f32x4*)(v0 + cc), b1 = *(const f32x4*)(v0 + cc + 4);
                                const float z[8] = {b0[0], b0[1], b0[2], b0[3], b1[0], b1[1], b1[2], b1[3]};
#pragma unroll
                                for (int j = 0; j < 8; ++j) r[j] = 1.0f - __expf(-0.6065306597126334f * sigmoidf_(z[j] + r[j]));
                                u32x4 w; w.x = pk_f16(r[0], r[1]); w.y = pk_f16(r[2], r[3]); w.z = pk_f16(r[4], r[5]); w.w = pk_f16(r[6], r[7]);
                                *(u32x4*)(O + row * 1024 + cc) = w;
                                continue;
                            } else if (region == 1) {
                                const f32x4 b0 = *(const f32x4*)(v1 + cc), b1 = *(const f32x4*)(v1 + cc + 4);
                                const float z[8] = {b0[0], b0[1], b0[2], b0[3], b1[0], b1[1], b1[2], b1[3]};
#pragma unroll
                                for (int j = 0; j < 8; ++j) r[j] = sigmoidf_(z[j] + r[j]);
                                dst = O2 + row * 1024 + cc;
                            } else dst = O3 + row * 1024 + cc;
                        }
                        if constexpr (MODE == EP_L2W) {
                            const f32x4 b0 = *(const f32x4*)(v0 + col), b1 = *(const f32x4*)(v0 + col + 4);
                            const float z[8] = {b0[0], b0[1], b0[2], b0[3], b1[0], b1[1], b1[2], b1[3]};
#pragma unroll
                            for (int j = 0; j < 8; ++j) r[j] = 1.0f - __expf(-0.6065306597126334f * sigmoidf_(z[j] + r[j]));
                            u32x4 w; w.x = pk_f16(r[0], r[1]); w.y = pk_f16(r[2], r[3]); w.z = pk_f16(r[4], r[5]); w.w = pk_f16(r[6], r[7]);
                            *(u32x4*)dst = w;
                            continue;
                        }
                        if constexpr (MODE == EP_L2A) {
                            const f32x4 b0 = *(const f32x4*)(v0 + col), b1 = *(const f32x4*)(v0 + col + 4);
                            const float z[8] = {b0[0], b0[1], b0[2], b0[3], b1[0], b1[1], b1[2], b1[3]};
#pragma unroll
                            for (int j = 0; j < 8; ++j) r[j] = sigmoidf_(z[j] + r[j]);
                        }
                        u32x4 w; w.x = cvt_pk_bf16(r[0], r[1]); w.y = cvt_pk_bf16(r[2], r[3]); w.z = cvt_pk_bf16(r[4], r[5]); w.w = cvt_pk_bf16(r[6], r[7]);
                        *(u32x4*)dst = w;
                    }
                }
            }
    }
};
template <int MODE> __device__ __forceinline__ void run_gemm(LAS unsigned char* lds, const bf16_t* A, const bf16_t* Bt, int N, int K, const Epi<MODE>& E) {
    pg8::Gemm g{A, Bt, M, N, K}; pg8::StaticOrder S; S.init(M, N, (int)gridDim.x, (int)blockIdx.x);
    pg8::gemm_phase<Epi<MODE>, pg8::StaticOrder, true, true>(lds, g, S, E);
}

#define XB_TMO      128
#define XB_XCNT(j)  (256  + 64 * (j))
#define XB_XSUB(j)  (1280 + 64 * (j))
#define XB_XGEN(j)  (2304 + 64 * (j))
#define XB_TOP      3328
#define XB_TOPGEN   3392
#define XCD_BAR_WORDS 3456
#define XB_SPIN_CAP (1u << 18)

__device__ __forceinline__ unsigned xb_ld(unsigned* p)              { return __hip_atomic_load(p, __ATOMIC_RELAXED, __HIP_MEMORY_SCOPE_AGENT); }
__device__ __forceinline__ unsigned xb_add(unsigned* p, unsigned v) { return __hip_atomic_fetch_add(p, v, __ATOMIC_RELAXED, __HIP_MEMORY_SCOPE_AGENT); }
__device__ __forceinline__ unsigned xb_xcc_id() { return (unsigned)__builtin_amdgcn_s_getreg((3 << 11) | 20) & 0xFu; }
#define XB_SPIN(cond, bar) do { unsigned _sp = 0; while (cond) { __builtin_amdgcn_s_sleep(1); \
    if ((++_sp & 255u) == 0u) { if (xb_ld(&(bar)[XB_TMO])) break; if (_sp > XB_SPIN_CAP) { atomicAdd(&(bar)[XB_TMO], 1u); break; } } } } while (0)

struct XcdBarrier {
    unsigned* bar; unsigned x;
    volatile LAS unsigned* st;
};

__device__ __forceinline__ XcdBarrier xcd_barrier_post(unsigned* bar, volatile LAS unsigned* st) {
    XcdBarrier b; b.bar = bar; b.x = xb_xcc_id(); b.st = st;
    if (threadIdx.x == 0) (void)xb_add(&bar[XB_XCNT(b.x)], 1u);
    return b;
}
__device__ __forceinline__ void xcd_barrier_complete(unsigned* bar, unsigned x, unsigned& nloc, unsigned& nx) {
    const unsigned G = gridDim.x * gridDim.y * gridDim.z;
    unsigned sum, cnt, mine, sp = 0u;
    for (;;) {
        sum = 0u; cnt = 0u; mine = 0u;
#pragma unroll
        for (unsigned j = 0; j < 16; ++j) { const unsigned c = xb_ld(&bar[XB_XCNT(j)]); sum += c; cnt += (c > 0u) ? 1u : 0u; mine = (j == x) ? c : mine; }
        if (sum == G) break;
        __builtin_amdgcn_s_sleep(1);
        if ((++sp & 255u) == 0u) { if (xb_ld(&bar[XB_TMO])) break; if (sp > XB_SPIN_CAP) { atomicAdd(&bar[XB_TMO], 1u); break; } }
    }
    nloc = mine > 0u ? mine : 1u; nx = cnt > 0u ? cnt : 1u;
}

__device__ __forceinline__ void xcd_barrier(const XcdBarrier& b) {
    asm volatile("s_waitcnt vmcnt(0)" ::: "memory");
    __syncthreads();
    if (threadIdx.x == 0) {
        unsigned* bar = b.bar;
        __builtin_amdgcn_s_waitcnt(0);
        unsigned nloc = b.st[0], nx = b.st[1];
        if (nloc == 0u) { xcd_barrier_complete(bar, b.x, nloc, nx); b.st[0] = nloc; b.st[1] = nx; }
        const unsigned old = xb_add(&bar[XB_XSUB(b.x)], 1u);
        const unsigned gen = old / nloc;
        if (old + 1u == (gen + 1u) * nloc) {
            __builtin_amdgcn_fence(__ATOMIC_RELEASE, "agent");
            asm volatile("s_waitcnt vmcnt(0)" ::: "memory");
            const unsigned og = xb_add(&bar[XB_TOP], 1u);
            const unsigned tg = og / nx;
            if (og + 1u == (tg + 1u) * nx) xb_add(&bar[XB_TOPGEN], 1u);
            else XB_SPIN(xb_ld(&bar[XB_TOPGEN]) == tg, bar);
            __builtin_amdgcn_fence(__ATOMIC_ACQUIRE, "agent");
            xb_add(&bar[XB_XGEN(b.x)], 1u);
            asm volatile("s_waitcnt vmcnt(0)" ::: "memory");
        } else {
            XB_SPIN(xb_ld(&bar[XB_XGEN(b.x)]) == gen, bar);
            __builtin_amdgcn_fence(__ATOMIC_ACQUIRE, "agent");
            asm volatile("s_waitcnt vmcnt(0)" ::: "memory");
        }
    }
    __syncthreads();
}


constexpr int TRP = 129;
struct TrJob { const float* src; int ld, c0, ncols, K; bf16_t* dst; int ldd, drow0, dk0; const float* rs; int rsmode; float cscale; };
__device__ __forceinline__ void tile_load(const TrJob& j, int t, float (&v)[16]) {
    const int tid = threadIdx.x, cc = tid & 127, kb = tid >> 7;
    const int nct = (j.ncols + 127) >> 7, ct = t % nct, k0 = (t / nct) * 64;
    int nc = j.ncols - ct * 128; if (nc > 128) nc = 128;
    const float* s = j.src + j.c0 + ct * 128 + cc;
#pragma unroll
    for (int p = 0; p < 16; ++p) { const int kk = k0 + kb + 4 * p; v[p] = (kk < j.K && cc < nc) ? s[(size_t)kk * j.ld] : 0.f; }
    if (j.rs) {
#pragma unroll
        for (int p = 0; p < 16; ++p) { const int kk = k0 + kb + 4 * p; if (kk < j.K) { const float mu = j.rs[kk]; v[p] *= j.rsmode ? mu : (1.0f - mu); } }
    }
}
__device__ __forceinline__ void tile_finish(LAS float* tile, const TrJob& j, int t, const float (&v)[16]) {
    const int tid = threadIdx.x, cc = tid & 127, kb = tid >> 7;
    const int nct = (j.ncols + 127) >> 7, ct = t % nct, k0 = (t / nct) * 64;
    int nc = j.ncols - ct * 128; if (nc > 128) nc = 128;
    __syncthreads();
#pragma unroll
    for (int p = 0; p < 16; ++p) tile[(kb + 4 * p) * TRP + cc] = v[p] * j.cscale;
    __syncthreads();
    const int n = tid >> 2, ks = tid & 3;
    if (n < nc) {
#pragma unroll
        for (int hf = 0; hf < 2; ++hf) {
            const int kq = ks * 16 + hf * 8;
            if (k0 + kq < j.K) {
                float r[8];
#pragma unroll
                for (int q = 0; q < 8; ++q) r[q] = tile[(kq + q) * TRP + n];
                u32x4 w; w.x = cvt_pk_bf16(r[0], r[1]); w.y = cvt_pk_bf16(r[2], r[3]); w.z = cvt_pk_bf16(r[4], r[5]); w.w = cvt_pk_bf16(r[6], r[7]);
                *(u32x4*)(j.dst + (size_t)(j.drow0 + ct * 128 + n) * j.ldd + j.dk0 + k0 + kq) = w;
            }
        }
    }
}
constexpr int NTILES = 2760;
__device__ __forceinline__ void tile_decode(const Args& a, int g, TrJob& j, int& t) {
    unsigned char* ws = a.ws; const float* w_in = a.in[8]; const float* mu = a.in[10];
    bf16_t* WA = (bf16_t*)(ws + WS_WA); bf16_t* WB = (bf16_t*)(ws + WS_WB); bf16_t* W2 = (bf16_t*)(ws + WS_W2);
    const float QS = 0.125f * 1.4426950408889634f;
    if (g < 192) { j = TrJob{w_in, 9728, 3072, 1536, 1024, WA, 1024, 0, 0, nullptr, 0, QS}; t = g; return; } g -= 192;
    if (g < 384) { j = TrJob{w_in, 9728, 4608, 3072, 1024, WA, 1024, 1536, 0, nullptr, 0, 1.0f}; t = g; return; } g -= 384;
    if (g < 384) { j = TrJob{w_in, 9728, 0, 3072, 1024, WB, 1024, 0, 0, nullptr, 0, 1.0f}; t = g; return; } g -= 384;
    if (g < 16) { j = TrJob{a.in[12], 64, 0, 64, 1024, WB, 1024, 3072, 0, mu, 0, 1.0f}; t = g; return; } g -= 16;
    if (g < 16) { j = TrJob{a.in[15], 64, 0, 64, 1024, WB, 1024, 3136, 0, mu + 1024, 0, 1.0f}; t = g; return; } g -= 16;
    if (g < 32) { j = TrJob{a.in[17], 160, 0, 160, 1024, WB, 1024, 3200, 0, mu + 2048, 0, 1.0f}; t = g; return; } g -= 32;
    if (g < 16) { j = TrJob{a.in[12], 64, 0, 64, 1024, WB, 1024, 3360, 0, mu, 1, 1.0f}; t = g; return; } g -= 16;
    if (g < 16) { j = TrJob{a.in[15], 64, 0, 64, 1024, WB, 1024, 3424, 0, mu + 1024, 1, 1.0f}; t = g; return; } g -= 16;
    if (g < 32) { j = TrJob{a.in[17], 160, 0, 160, 1024, WB, 1024, 3488, 0, mu + 2048, 1, 1.0f}; t = g; return; } g -= 32;
    if (g < 256) { j = TrJob{w_in, 9728, 7680, 2048, 1024, (bf16_t*)(ws + WS_WC), 1024, 0, 0, nullptr, 0, 1.0f}; t = g; return; } g -= 256;
    if (g < 128) { j = TrJob{a.in[24], 1024, 0, 1024, 1024, (bf16_t*)(ws + WS_WOR), 1024, 0, 0, nullptr, 0, 1.0f}; t = g; return; } g -= 128;
    if (g < 64) { j = TrJob{a.in[25], 1024, 0, 1024, 512, (bf16_t*)(ws + WS_WOA), 512, 0, 0, nullptr, 0, 1.0f}; t = g; return; } g -= 64;
    if (g < 128) { j = TrJob{a.in[26], 1024, 0, 1024, 1024, (bf16_t*)(ws + WS_WOUT), 1024, 0, 0, nullptr, 0, 1.0f}; t = g; return; } g -= 128;
    if (g < 352) { j = TrJob{a.in[28], 1024, 0, 1024, 2816, (bf16_t*)(ws + WS_WFO), 2816, 0, 0, nullptr, 0, 1.0f}; t = g; return; } g -= 352;
    if (g < 704) { const int s = g >> 4, pn = s >> 1, bj = s & 1;
                   j = TrJob{a.in[27], 5632, bj * 2816 + pn * 128, 128, 1024, (bf16_t*)(ws + WS_WFI), 1024, pn * 256 + bj * 128, 0, nullptr, 0, 1.0f}; t = g & 15; return; } g -= 704;
    if (g < 8) { j = TrJob{a.in[13], 1024, 0, 1024, 64, W2, 384, 0, 0, nullptr, 0, 1.0f}; t = g; return; } g -= 8;
    if (g < 8) { j = TrJob{a.in[16], 1024, 0, 1024, 64, W2, 384, 1024, 64, nullptr, 0, 1.0f}; t = g; return; } g -= 8;
    j = TrJob{a.in[18], 1024, 0, 1024, 160, W2, 384, 2048, 128, nullptr, 0, 1.0f}; t = g;
}
__device__ __forceinline__ void p0_prologue(const Args& a, LAS unsigned char* lds) {
    LAS float* tile = (LAS float*)lds;
    unsigned char* ws = a.ws;
    const int tid = threadIdx.x, G = gridDim.x, bx = blockIdx.x;
    const float* w_in = a.in[8]; const float* mu_lora = a.in[10];
    bf16_t* WA = (bf16_t*)(ws + WS_WA); bf16_t* WB = (bf16_t*)(ws + WS_WB); bf16_t* WC = (bf16_t*)(ws + WS_WC); bf16_t* W2 = (bf16_t*)(ws + WS_W2);
    {
        const float* c = a.in[1]; const float* w_mod = a.in[2]; const float* b_mod = a.in[3];
        float* MOD = (float*)(ws + WS_MOD);
        LAS float* red = (LAS float*)lds;
        for (int cb = bx; cb < 256; cb += G) {
            const int col = tid % 24, kg = tid / 24;
            float s0 = 0.f, s1 = 0.f, s2 = 0.f, s3 = 0.f;
            if (kg < 21)
#pragma unroll 7
            for (int k = kg; k < 1024; k += 21) { const float w = w_mod[(size_t)k * 6144 + cb * 24 + col]; s0 += c[k] * w; s1 += c[1024 + k] * w; s2 += c[2048 + k] * w; s3 += c[3072 + k] * w; }
            __syncthreads();
            if (kg < 21) { red[(kg * 24 + col) * 4 + 0] = s0; red[(kg * 24 + col) * 4 + 1] = s1; red[(kg * 24 + col) * 4 + 2] = s2; red[(kg * 24 + col) * 4 + 3] = s3; }
            __syncthreads();
            if (tid < 96) { const int cc = tid % 24, b = tid / 24; float s = 0.f; for (int g = 0; g < 21; ++g) s += red[(g * 24 + cc) * 4 + b]; MOD[b * 6144 + cb * 24 + cc] = s + b_mod[cb * 24 + cc]; }
        }
        __syncthreads();
    }
    {
        int g = bx, t = 0, tn = 0; TrJob j{}, jn{}; float v[16], vn[16];
        if (g < NTILES) { tile_decode(a, g, j, t); tile_load(j, t, v); }
        while (g < NTILES) {
            const int gn = g + G;
            if (gn < NTILES) { tile_decode(a, gn, jn, tn); tile_load(jn, tn, vn); }
            tile_finish(tile, j, t, v);
            j = jn; t = tn; g = gn;
#pragma unroll
            for (int p2 = 0; p2 < 16; ++p2) v[p2] = vn[p2];
        }
    }
    for (int i = bx * NTHR + tid; i < 192 * 1024 / 8; i += G * NTHR) ((u32x4*)(WB + (size_t)3648 * 1024))[i] = (u32x4){0u, 0u, 0u, 0u};
    for (int i = bx * NTHR + tid; i < 1024 * 108; i += G * NTHR) {
        const int row = i / 108, c = i % 108;
        int n, k8;
        if (c < 40) { n = row; k8 = 8 + c; }
        else if (c < 80) { n = 1024 + row; k8 = (c - 40) < 8 ? (c - 40) : (c - 40) + 8; }
        else { n = 2048 + row; k8 = (c - 80) < 16 ? (c - 80) : (c - 80) + 20; }
        *(u32x4*)(W2 + (size_t)n * 384 + k8 * 8) = (u32x4){0u, 0u, 0u, 0u};
    }
}

constexpr int RPW = 16;
__device__ __forceinline__ void p1_prenorm(const Args& a) {
    const int lane = threadIdx.x & 63, wave = threadIdx.x >> 6;
    const float* x = a.in[0]; const float* gpre = a.in[4]; const float* MOD = (const float*)(a.ws + WS_MOD); bf16_t* HB = (bf16_t*)(a.ws + WS_HB);
    for (int base = (blockIdx.x * 8 + wave) * RPW; base < M; base += gridDim.x * 8 * RPW) {
        const float* mod = MOD + (base / T) * 6144;
        f32x4 g[4], sh[4], sc[4];
#pragma unroll
        for (int i = 0; i < 4; ++i) { const int c = i * 256 + lane * 4; g[i] = *(const f32x4*)(gpre + c); sh[i] = *(const f32x4*)(mod + c); sc[i] = *(const f32x4*)(mod + 1024 + c) + 1.0f; }
        f32x4 v[4];
#pragma unroll
        for (int i = 0; i < 4; ++i) v[i] = ((const f32x4*)(x + (size_t)base * D))[i * 64 + lane];
#pragma unroll 2
        for (int k = 0; k < RPW; ++k) {
            const int row = base + k, rn = (k + 1 < RPW) ? row + 1 : row;
            f32x4 vn[4];
#pragma unroll
            for (int i = 0; i < 4; ++i) vn[i] = ((const f32x4*)(x + (size_t)rn * D))[i * 64 + lane];
            float ss = 0.f;
#pragma unroll
            for (int i = 0; i < 4; ++i) ss += v[i][0] * v[i][0] + v[i][1] * v[i][1] + v[i][2] * v[i][2] + v[i][3] * v[i][3];
            ss = wave_sum(ss);
            const float rs = rsqrtf(ss * (1.0f / D) + 1e-6f);
#pragma unroll
            for (int i = 0; i < 4; ++i) {
                float r[4];
#pragma unroll
                for (int j = 0; j < 4; ++j) r[j] = (v[i][j] * rs * g[i][j]) * sc[i][j] + sh[i][j];
                u32x2 w; w.x = cvt_pk_bf16(r[0], r[1]); w.y = cvt_pk_bf16(r[2], r[3]);
                *(u32x2*)(HB + (size_t)row * D + i * 256 + lane * 4) = w;
            }
#pragma unroll
            for (int i = 0; i < 4; ++i) v[i] = vn[i];
        }
    }
}
__device__ __forceinline__ void p13_mid(const Args& a) {
    const int lane = threadIdx.x & 63, wave = threadIdx.x >> 6;
    const float* x = a.in[0]; const float* gpost = a.in[5]; const float* gpre2 = a.in[6]; const float* MOD = (const float*)(a.ws + WS_MOD);
    const bf16_t* MX = (const bf16_t*)(a.ws + WS_MIXED); bf16_t* HB = (bf16_t*)(a.ws + WS_HB); float* out = a.out;
    for (int base = (blockIdx.x * 8 + wave) * RPW; base < M; base += gridDim.x * 8 * RPW) {
        const float* mod = MOD + (base / T) * 6144;
        f32x4 gg[4], g2[4], sh[4], sc[4];
#pragma unroll
        for (int i = 0; i < 4; ++i) { const int c = i * 256 + lane * 4; gg[i] = *(const f32x4*)(gpost + c) * *(const f32x4*)(mod + 2048 + c); g2[i] = *(const f32x4*)(gpre2 + c);
                                      sh[i] = *(const f32x4*)(mod + 3072 + c); sc[i] = *(const f32x4*)(mod + 4096 + c) + 1.0f; }
        u32x2 m[4]; f32x4 xv[4];
#pragma unroll
        for (int i = 0; i < 4; ++i) { m[i] = *(const u32x2*)(MX + (size_t)base * D + i * 256 + lane * 4); xv[i] = *(const f32x4*)(x + (size_t)base * D + i * 256 + lane * 4); }
#pragma unroll 2
        for (int k = 0; k < RPW; ++k) {
            const int row = base + k, rn = (k + 1 < RPW) ? row + 1 : row;
            u32x2 mn[4]; f32x4 xn[4];
#pragma unroll
            for (int i = 0; i < 4; ++i) { mn[i] = *(const u32x2*)(MX + (size_t)rn * D + i * 256 + lane * 4); xn[i] = *(const f32x4*)(x + (size_t)rn * D + i * 256 + lane * 4); }
            f32x4 v[4]; float ss = 0.f;
#pragma unroll
            for (int i = 0; i < 4; ++i) { v[i] = (f32x4){lo_bf(m[i].x), hi_bf(m[i].x), lo_bf(m[i].y), hi_bf(m[i].y)}; ss += v[i][0] * v[i][0] + v[i][1] * v[i][1] + v[i][2] * v[i][2] + v[i][3] * v[i][3]; }
            ss = wave_sum(ss);
            const float rs = rsqrtf(ss * (1.0f / D) + 1e-6f);
            float ss2 = 0.f;
#pragma unroll
            for (int i = 0; i < 4; ++i) {
#pragma unroll
                for (int j = 0; j < 4; ++j) { v[i][j] = xv[i][j] + gg[i][j] * (v[i][j] * rs); ss2 += v[i][j] * v[i][j]; }
            }
            ss2 = wave_sum(ss2);
            const float rs2 = rsqrtf(ss2 * (1.0f / D) + 1e-6f);
#pragma unroll
            for (int i = 0; i < 4; ++i) {
                float r[4];
#pragma unroll
                for (int j = 0; j < 4; ++j) r[j] = (v[i][j] * rs2 * g2[i][j]) * sc[i][j] + sh[i][j];
                u32x2 w; w.x = cvt_pk_bf16(r[0], r[1]); w.y = cvt_pk_bf16(r[2], r[3]);
                *(u32x2*)(HB + (size_t)row * D + i * 256 + lane * 4) = w;
            }
#pragma unroll
            for (int i = 0; i < 4; ++i) { m[i] = mn[i]; xv[i] = xn[i]; }
        }
    }
}
__device__ __forceinline__ void p16_final(const Args& a) {
    const int lane = threadIdx.x & 63, wave = threadIdx.x >> 6;
    const float* x = a.in[0]; const float* gpm = a.in[5]; const float* gpost = a.in[7]; const float* MOD = (const float*)(a.ws + WS_MOD);
    const bf16_t* MX = (const bf16_t*)(a.ws + WS_MIXED); const bf16_t* Y2 = (const bf16_t*)(a.ws + WS_Y2); float* out = a.out;
    for (int base = (blockIdx.x * 8 + wave) * RPW; base < M; base += gridDim.x * 8 * RPW) {
        const float* mod = MOD + (base / T) * 6144;
        f32x4 gm[4], gg[4];
#pragma unroll
        for (int i = 0; i < 4; ++i) { const int c = i * 256 + lane * 4; gm[i] = *(const f32x4*)(gpm + c) * *(const f32x4*)(mod + 2048 + c); gg[i] = *(const f32x4*)(gpost + c) * *(const f32x4*)(mod + 5120 + c); }
        u32x2 m[4], y[4]; f32x4 xv[4];
#pragma unroll
        for (int i = 0; i < 4; ++i) { const size_t o = (size_t)base * D + i * 256 + lane * 4; m[i] = *(const u32x2*)(MX + o); y[i] = *(const u32x2*)(Y2 + o); xv[i] = *(const f32x4*)(x + o); }
#pragma unroll 2
        for (int k = 0; k < RPW; ++k) {
            const int row = base + k, rn = (k + 1 < RPW) ? row + 1 : row;
            u32x2 mn[4], yn[4]; f32x4 xn[4];
#pragma unroll
            for (int i = 0; i < 4; ++i) { const size_t o = (size_t)rn * D + i * 256 + lane * 4; mn[i] = *(const u32x2*)(MX + o); yn[i] = *(const u32x2*)(Y2 + o); xn[i] = *(const f32x4*)(x + o); }
            f32x4 vm[4], vy[4]; float s1 = 0.f, s2 = 0.f;
#pragma unroll
            for (int i = 0; i < 4; ++i) { vm[i] = (f32x4){lo_bf(m[i].x), hi_bf(m[i].x), lo_bf(m[i].y), hi_bf(m[i].y)}; vy[i] = (f32x4){lo_bf(y[i].x), hi_bf(y[i].x), lo_bf(y[i].y), hi_bf(y[i].y)};
                s1 += vm[i][0] * vm[i][0] + vm[i][1] * vm[i][1] + vm[i][2] * vm[i][2] + vm[i][3] * vm[i][3]; s2 += vy[i][0] * vy[i][0] + vy[i][1] * vy[i][1] + vy[i][2] * vy[i][2] + vy[i][3] * vy[i][3]; }
            s1 = wave_sum(s1); s2 = wave_sum(s2);
            const float r1 = rsqrtf(s1 * (1.0f / D) + 1e-6f), r2 = rsqrtf(s2 * (1.0f / D) + 1e-6f);
#pragma unroll
            for (int i = 0; i < 4; ++i) {
                f32x4 o;
#pragma unroll
                for (int j = 0; j < 4; ++j) { const float x1 = xv[i][j] + gm[i][j] * (vm[i][j] * r1); o[j] = x1 + gg[i][j] * (vy[i][j] * r2); }
                *(f32x4*)(out + (size_t)row * D + i * 256 + lane * 4) = o;
            }
#pragma unroll
            for (int i = 0; i < 4; ++i) { m[i] = mn[i]; y[i] = yn[i]; xv[i] = xn[i]; }
        }
    }
}
__device__ __forceinline__ void p6_loramid(const Args& a) {
    const bf16_t* P = (const bf16_t*)(a.ws + WS_P); bf16_t* A2 = (bf16_t*)(a.ws + WS_A2);
    for (int i = blockIdx.x * NTHR + threadIdx.x; i < M * 192; i += gridDim.x * NTHR) {
        const int tok = i / 192, c = (i % 192) * 2;
        float h0 = 0.f, h1 = 0.f;
        if (c < 288) {
            const unsigned cur = *(const unsigned*)(P + (size_t)tok * 768 + c);
            h0 = lo_bf(cur); h1 = hi_bf(cur);
            if ((tok & (T - 1)) != 0) { const unsigned prv = *(const unsigned*)(P + (size_t)(tok - 1) * 768 + 288 + c); h0 += lo_bf(prv); h1 += hi_bf(prv); }
            if (c < 64) { h0 = 1.0f - 2.0f * __builtin_amdgcn_rcpf(__expf(2.0f * h0) + 1.0f); h1 = 1.0f - 2.0f * __builtin_amdgcn_rcpf(__expf(2.0f * h1) + 1.0f); }
            else if (c >= 128) { h0 = sigmoidf_(h0); h1 = sigmoidf_(h1); }
        }
        *(unsigned*)(A2 + (size_t)tok * 384 + c) = cvt_pk_bf16(h0, h1);
    }
}
__device__ __forceinline__ void p4_combine(const Args& a) {
    const bf16_t* OG = (const bf16_t*)((const unsigned char*)a.out + OUT_OG); const float* LSE = (const float*)((const unsigned char*)a.out + OUT_LSE);
    bf16_t* OATT = (bf16_t*)(a.ws + WS_OATT);
    for (int i = blockIdx.x * NTHR + threadIdx.x; i < M * 64; i += gridDim.x * NTHR) {
        const int tok = i >> 6, seg = i & 63, hh = seg >> 3;
        const float l0 = LSE[(size_t)tok * 8 + hh], l1 = LSE[(size_t)M * 8 + (size_t)tok * 8 + hh], l2 = LSE[(size_t)2 * M * 8 + (size_t)tok * 8 + hh];
        const float mx = fmaxf(l0, fmaxf(l1, l2));
        float w0 = __expf(l0 - mx), w1 = __expf(l1 - mx), w2 = __expf(l2 - mx);
        const float inv = __builtin_amdgcn_rcpf(w0 + w1 + w2); w0 *= inv; w1 *= inv; w2 *= inv;
        const u32x4 o0 = *(const u32x4*)(OG + (size_t)tok * 512 + seg * 8), o1 = *(const u32x4*)(OG + (size_t)M * 512 + (size_t)tok * 512 + seg * 8),
                    o2 = *(const u32x4*)(OG + (size_t)2 * M * 512 + (size_t)tok * 512 + seg * 8);
        u32x4 w;
        w.x = cvt_pk_bf16(w0 * lo_bf(o0.x) + w1 * lo_bf(o1.x) + w2 * lo_bf(o2.x), w0 * hi_bf(o0.x) + w1 * hi_bf(o1.x) + w2 * hi_bf(o2.x));
        w.y = cvt_pk_bf16(w0 * lo_bf(o0.y) + w1 * lo_bf(o1.y) + w2 * lo_bf(o2.y), w0 * hi_bf(o0.y) + w1 * hi_bf(o1.y) + w2 * hi_bf(o2.y));
        w.z = cvt_pk_bf16(w0 * lo_bf(o0.z) + w1 * lo_bf(o1.z) + w2 * lo_bf(o2.z), w0 * hi_bf(o0.z) + w1 * hi_bf(o1.z) + w2 * hi_bf(o2.z));
        w.w = cvt_pk_bf16(w0 * lo_bf(o0.w) + w1 * lo_bf(o1.w) + w2 * lo_bf(o2.w), w0 * hi_bf(o0.w) + w1 * hi_bf(o1.w) + w2 * hi_bf(o2.w));
        *(u32x4*)(OATT + (size_t)tok * 512 + seg * 8) = w;
    }
}

constexpr int QP = 72, VP = 392;
constexpr int ATT_Q = 0, ATT_K = 256 * QP * 2, ATT_V = ATT_K + 384 * QP * 2;
constexpr int ATT_ITEMS = 3072;
struct AttItem { int g, b, hh, r, n, dsh; };
__device__ __forceinline__ AttItem att_decode(int item) {
    AttItem it; it.g = item / 1024; it.b = (item >> 8) & 3; it.hh = (item >> 5) & 7; const int rb = item & 31;
    it.dsh = 2 * it.g; const int nbk = 32 >> it.dsh; it.r = rb / nbk; it.n = 2 * (rb % nbk); return it;
}
__device__ __forceinline__ void att_load(const bf16_t* QKVA, const AttItem& it, int tid, u32x4 (&q)[4], u32x4 (&k)[6], u32x4 (&v)[6]) {
    const size_t SEC = (size_t)3 * 8 * 4 * T * 64;
    const int L = T >> it.dsh;
    const bf16_t* base = QKVA + ((((size_t)(it.g * 8 + it.hh) * 4 + it.b) * T + (size_t)it.r * L) << 6);
#pragma unroll
    for (int i = 0; i < 4; ++i) { const int p = tid + i * NTHR, row = p >> 3, seg = p & 7;
        q[i] = *(const u32x4*)(base + ((size_t)(128 * it.n + row) << 6) + seg * 8); }
#pragma unroll
    for (int i = 0; i < 6; ++i) { const int p = tid + i * NTHR, row = p >> 3, seg = p & 7; const int uu = 128 * (it.n - 1) + row;
        k[i] = (u32x4){0u, 0u, 0u, 0u};
        if (uu >= 0) k[i] = *(const u32x4*)(base + SEC + ((size_t)uu << 6) + seg * 8); }
#pragma unroll
    for (int i = 0; i < 3; ++i) { const int idx = tid + i * NTHR, kp = idx % 192, seg = idx / 192; const int uu = 128 * (it.n - 1) + 2 * kp;
        v[2 * i] = (u32x4){0u, 0u, 0u, 0u}; v[2 * i + 1] = (u32x4){0u, 0u, 0u, 0u};
        if (uu >= 0) { const bf16_t* vp = base + 2 * SEC + ((size_t)uu << 6) + seg * 8;
                       v[2 * i] = *(const u32x4*)vp; v[2 * i + 1] = *(const u32x4*)(vp + 64); } }
}
__device__ __forceinline__ void att_store(LAS bf16_t* Qs, LAS bf16_t* Ks, LAS bf16_t* Vt, int tid, const u32x4 (&q)[4], const u32x4 (&k)[6], const u32x4 (&v)[6]) {
#pragma unroll
    for (int i = 0; i < 4; ++i) { const int p = tid + i * NTHR, row = p >> 3, seg = p & 7; *(LAS u32x4*)(Qs + row * QP + seg * 8) = q[i]; }
#pragma unroll
    for (int i = 0; i < 6; ++i) { const int p = tid + i * NTHR, row = p >> 3, seg = p & 7; *(LAS u32x4*)(Ks + row * QP + seg * 8) = k[i]; }
#pragma unroll
    for (int i = 0; i < 3; ++i) { const int idx = tid + i * NTHR, kp = idx % 192, seg = idx / 192;
        const int k0 = 2 * kp, vpos = (k0 & ~31) + 8 * ((k0 >> 2) & 3) + 4 * ((k0 >> 4) & 1) + (k0 & 3);
        LAS unsigned* vd = (LAS unsigned*)(Vt + (seg * 8) * VP + vpos);
        const u32x4 a = v[2 * i], b2 = v[2 * i + 1];
        vd[0 * (VP / 2)] = (a.x & 0xffffu) | (b2.x << 16); vd[1 * (VP / 2)] = (a.x >> 16) | (b2.x & 0xffff0000u);
        vd[2 * (VP / 2)] = (a.y & 0xffffu) | (b2.y << 16); vd[3 * (VP / 2)] = (a.y >> 16) | (b2.y & 0xffff0000u);
        vd[4 * (VP / 2)] = (a.z & 0xffffu) | (b2.z << 16); vd[5 * (VP / 2)] = (a.z >> 16) | (b2.z & 0xffff0000u);
        vd[6 * (VP / 2)] = (a.w & 0xffffu) | (b2.w << 16); vd[7 * (VP / 2)] = (a.w >> 16) | (b2.w & 0xffff0000u); }
}
__device__ __forceinline__ void p3_attention(const Args& a, LAS unsigned char* lds) {
    const int tid = threadIdx.x, lane = tid & 63, w = tid >> 6, l15 = lane & 15, q4 = lane >> 4;
    const bf16_t* QKVA = (const bf16_t*)(a.ws + WS_QKVA);
    bf16_t* OG = (bf16_t*)((unsigned char*)a.out + OUT_OG); float* LSE = (float*)((unsigned char*)a.out + OUT_LSE);
    LAS bf16_t* Qs = (LAS bf16_t*)(lds + ATT_Q); LAS bf16_t* Ks = (LAS bf16_t*)(lds + ATT_K); LAS bf16_t* Vt = (LAS bf16_t*)(lds + ATT_V);
    const int G = gridDim.x, bx = blockIdx.x;
    const int vcu = (G % 8 == 0) ? (bx % 8) * (G / 8) + bx / 8 : bx;
    u32x4 rq[4], rk[6], rv[6];
    int item = vcu;
    if (item < ATT_ITEMS) { const AttItem it = att_decode(item); att_load(QKVA, it, tid, rq, rk, rv); }
    __syncthreads();
    if (item < ATT_ITEMS) att_store(Qs, Ks, Vt, tid, rq, rk, rv);
    __syncthreads();
    for (; item < ATT_ITEMS; item += G) {
        const AttItem it = att_decode(item);
        const int g = it.g, b = it.b, hh = it.hh, r = it.r, dsh = it.dsh, d = 1 << dsh;
        const int nxt = item + G;
        if (nxt < ATT_ITEMS) { const AttItem itn = att_decode(nxt); att_load(QKVA, itn, tid, rq, rk, rv); }
        const int cb = 32 * (w >> 1);
        const int iq = 16 * w + l15;
#pragma unroll
        for (int sb = 0; sb < 2; ++sb) {
        const int n = it.n + sb, qo = 128 * sb, cbs = 128 * sb + cb;
        bf16x8 qf[2];
#pragma unroll
        for (int ks = 0; ks < 2; ++ks) qf[ks] = *(const LAS bf16x8*)(Qs + (qo + iq) * QP + ks * 32 + q4 * 8);
        f32x4 s[10];
#pragma unroll
        for (int i = 0; i < 10; ++i) {
            s[i] = (f32x4){0.f, 0.f, 0.f, 0.f};
#pragma unroll
            for (int ks = 0; ks < 2; ++ks) { const bf16x8 kf = *(const LAS bf16x8*)(Ks + (cbs + 16 * i + l15) * QP + ks * 32 + q4 * 8);
                s[i] = __builtin_amdgcn_mfma_f32_16x16x32_bf16(kf, qf[ks], s[i], 0, 0, 0); }
        }
        const int sidx = 8 * g + hh;
        const float nslope = -1.4426950408889634f * exp2f(sidx < 16 ? -0.25f * (float)(sidx + 1) : -4.0f - 0.5f * (float)(sidx - 15)) * (float)d;
        const float basef = (float)(iq - cb - 4 * q4 + 128);
        const float dhi = (n > 0) ? 128.0f : fminf(128.0f, (float)iq);
        float mx = -1e30f;
#pragma unroll
        for (int i = 0; i < 10; ++i)
#pragma unroll
            for (int j = 0; j < 4; ++j) { const float dl = basef - (float)(16 * i + j);
                const bool valid = __builtin_fmaxf(__builtin_fminf(dl, dhi), 0.0f) == dl;
                const float v = valid ? __builtin_fmaf(nslope, dl, s[i][j]) : -1e30f; s[i][j] = v; mx = fmaxf(mx, v); }
        { const int xi = __float_as_int(mx); const auto r16 = __builtin_amdgcn_permlane16_swap(xi, xi, false, false); mx = fmaxf(__int_as_float(r16[0]), __int_as_float(r16[1]));
          const int yi = __float_as_int(mx); const auto r32 = __builtin_amdgcn_permlane32_swap(yi, yi, false, false); mx = fmaxf(__int_as_float(r32[0]), __int_as_float(r32[1])); }
        float den = 0.f;
#pragma unroll
        for (int i = 0; i < 10; ++i)
#pragma unroll
            for (int j = 0; j < 4; ++j) { const float p = __builtin_amdgcn_exp2f(s[i][j] - mx); s[i][j] = p; den += p; }
        { const int xi = __float_as_int(den); const auto r16 = __builtin_amdgcn_permlane16_swap(xi, xi, false, false); den = __int_as_float(r16[0]) + __int_as_float(r16[1]);
          const int yi = __float_as_int(den); const auto r32 = __builtin_amdgcn_permlane32_swap(yi, yi, false, false); den = __int_as_float(r32[0]) + __int_as_float(r32[1]); }
        f32x4 o[4];
#pragma unroll
        for (int dt = 0; dt < 4; ++dt) o[dt] = (f32x4){0.f, 0.f, 0.f, 0.f};
#pragma unroll
        for (int c = 0; c < 5; ++c) {
            u32x4 pw; pw.x = cvt_pk_bf16(s[2 * c][0], s[2 * c][1]); pw.y = cvt_pk_bf16(s[2 * c][2], s[2 * c][3]); pw.z = cvt_pk_bf16(s[2 * c + 1][0], s[2 * c + 1][1]); pw.w = cvt_pk_bf16(s[2 * c + 1][2], s[2 * c + 1][3]);
            const bf16x8 pf = __builtin_bit_cast(bf16x8, pw);
#pragma unroll
            for (int dt = 0; dt < 4; ++dt) {
                const bf16x8 vf = *(const LAS bf16x8*)(Vt + (dt * 16 + l15) * VP + cbs + 32 * c + 8 * q4);
                o[dt] = __builtin_amdgcn_mfma_f32_16x16x32_bf16(vf, pf, o[dt], 0, 0, 0);
            }
        }
        const float inv = __builtin_amdgcn_rcpf(den);
        const size_t tok = (size_t)b * T + (((128 * n + iq) << dsh) + r);
        bf16_t* op = OG + (size_t)g * M * 512 + tok * 512 + hh * 64 + q4 * 4;
#pragma unroll
        for (int dt = 0; dt < 4; ++dt) { u32x2 ww; ww.x = cvt_pk_bf16(o[dt][0] * inv, o[dt][1] * inv); ww.y = cvt_pk_bf16(o[dt][2] * inv, o[dt][3] * inv); *(u32x2*)(op + dt * 16) = ww; }
        if (q4 == 0) LSE[(size_t)g * M * 8 + tok * 8 + hh] = (mx + __builtin_amdgcn_logf(den)) * 0.6931471805599453f;
        }
        __syncthreads();
        if (nxt < ATT_ITEMS) att_store(Qs, Ks, Vt, tid, rq, rk, rv);
        __syncthreads();
    }
}

constexpr int TC = 32, SPITCH = 392;
typedef float f32x2 __attribute__((ext_vector_type(2)));
template <int CTRL> __device__ __forceinline__ float dpp_f(float x) { return __int_as_float(__builtin_amdgcn_update_dpp(0, __float_as_int(x), CTRL, 0xf, 0xf, false)); }
struct ScanRegs { u32x2 pr, pk, pv, qr, qk, qv, wl, as; };
__device__ __forceinline__ void scan_issue(ScanRegs& R, const bf16_t* PRKV, const unsigned short* WLOG, const bf16_t* ASIG, size_t tok, int ch, int want_prev) {
    const bf16_t* pp = PRKV + tok * 3072 + ch;
    R.pr = *(const u32x2*)pp; R.pk = *(const u32x2*)(pp + 1024); R.pv = *(const u32x2*)(pp + 2048);
    R.qr = (u32x2){0u, 0u}; R.qk = (u32x2){0u, 0u}; R.qv = (u32x2){0u, 0u};
    if (want_prev == 1) { R.qr = *(const u32x2*)(pp - 3072); R.qk = *(const u32x2*)(pp - 3072 + 1024); R.qv = *(const u32x2*)(pp - 3072 + 2048); }
    R.wl = *(const u32x2*)(WLOG + tok * 1024 + ch); R.as = *(const u32x2*)(ASIG + tok * 1024 + ch);
}
__device__ __forceinline__ void unpack4(const u32x2 u, float (&f)[4]) { f[0] = lo_bf(u.x); f[1] = hi_bf(u.x); f[2] = lo_bf(u.y); f[3] = hi_bf(u.y); }
__device__ __forceinline__ float scan_prepare(const ScanRegs& R, const u32x2 qr_, const u32x2 qk_, const u32x2 qv_, LAS float* slot, int cq, const f32x4 mur, const f32x4 muk, const f32x4 muv, const f32x4 kkc, const f32x4 kac, const f32x4 rkc) {
    float pr[4], pk[4], pv[4], qr[4], qk[4], qv[4], av[4], om[4];
    unpack4(R.pr, pr); unpack4(R.pk, pk); unpack4(R.pv, pv); unpack4(qr_, qr); unpack4(qk_, qk); unpack4(qv_, qv); unpack4(R.as, av);
    om[0] = f16_to_f((unsigned short)(R.wl.x & 0xffffu)); om[1] = f16_to_f((unsigned short)(R.wl.x >> 16)); om[2] = f16_to_f((unsigned short)(R.wl.y & 0xffffu)); om[3] = f16_to_f((unsigned short)(R.wl.y >> 16));
    float rr[4], vv[4], kn[4], k2[4], dec[4], bu[4];
    float ssq = 0.f, bon = 0.f, c1 = 0.f, c2 = 0.f;
#pragma unroll
    for (int j = 0; j < 4; ++j) {
        rr[j] = pr[j] + (qr[j] - pr[j]) * mur[j]; const float kk0 = pk[j] + (qk[j] - pk[j]) * muk[j]; vv[j] = pv[j] + (qv[j] - pv[j]) * muv[j];
        dec[j] = 1.0f - om[j];
        kn[j] = kk0 * kkc[j]; ssq += kn[j] * kn[j];
        k2[j] = kk0 * (1.0f + (av[j] - 1.0f) * kac[j]);
        const float t = rr[j] * k2[j]; bon += t * rkc[j]; c2 += t;
        bu[j] = kn[j] * av[j]; c1 += bu[j] * rr[j];
    }
    ssq += dpp_f<0x121>(ssq); bon += dpp_f<0x121>(bon); c1 += dpp_f<0x121>(c1); c2 += dpp_f<0x121>(c2);
    ssq += dpp_f<0x122>(ssq); bon += dpp_f<0x122>(bon); c1 += dpp_f<0x122>(c1); c2 += dpp_f<0x122>(c2);
    ssq += dpp_f<0x124>(ssq); bon += dpp_f<0x124>(bon); c1 += dpp_f<0x124>(c1); c2 += dpp_f<0x124>(c2);
    ssq += dpp_f<0x128>(ssq); bon += dpp_f<0x128>(bon); c1 += dpp_f<0x128>(c1); c2 += dpp_f<0x128>(c2);
    const float inv = __builtin_amdgcn_rsqf(fmaxf(ssq, 1e-24f));
    f32x4 o_al, o_be, o_wr;
#pragma unroll
    for (int j = 0; j < 4; ++j) { o_al[j] = -(kn[j] * inv); o_be[j] = bu[j] * inv; o_wr[j] = dec[j] * rr[j]; }
    LAS f32x4* s4 = (LAS f32x4*)slot;
    s4[cq] = (f32x4){dec[0], dec[1], dec[2], dec[3]}; s4[16 + cq] = (f32x4){k2[0], k2[1], k2[2], k2[3]}; s4[32 + cq] = o_al; s4[48 + cq] = o_be; s4[64 + cq] = o_wr;
    s4[80 + cq] = (f32x4){vv[0], vv[1], vv[2], vv[3]};
    if (cq == 0) *(LAS f32x2*)(slot + 384) = (f32x2){c1 * inv, c2};
    return bon;
}
__device__ __forceinline__ float ysum4(const LAS float* p) { const f32x4 a = *(const LAS f32x4*)p; return (a[0] + a[1]) + (a[2] + a[3]); }
struct ScanOps { f32x4 wv, kv, al, be, wr; f32x2 cc; float vi; };
__device__ __forceinline__ void scan_ld(ScanOps& o, const LAS float* sl, int jq4, int myrow) {
    o.al = *(const LAS f32x4*)(sl + 128 + jq4); o.wr = *(const LAS f32x4*)(sl + 256 + jq4); o.vi = sl[320 + myrow]; o.kv = *(const LAS f32x4*)(sl + 64 + jq4);
    o.be = *(const LAS f32x4*)(sl + 192 + jq4); o.wv = *(const LAS f32x4*)(sl + jq4); o.cc = *(const LAS f32x2*)(sl + 384);
}
__device__ __forceinline__ void p8_scan(const Args& a, LAS unsigned char* lds) {
    const int tid = threadIdx.x, lane = tid & 63, w = __builtin_amdgcn_readfirstlane(tid >> 6);
    const bf16_t* PRKV = (const bf16_t*)(a.ws + WS_PRKV); const unsigned short* WLOG = (const unsigned short*)(a.ws + WS_WLOG);
    const bf16_t* ASIG = (const bf16_t*)((const unsigned char*)a.out + OUT_ASIG);
    bf16_t* Y = (bf16_t*)(a.ws + WS_Y); float* BONUS = (float*)(a.ws + WS_BONUS);
    const float* mu_rkv = a.in[9]; const float* k_k = a.in[19]; const float* k_a = a.in[20]; const float* r_k = a.in[21];
    LAS float* buf = (LAS float*)lds;
    LAS float* ybuf = (LAS float*)(lds + 2 * TC * SPITCH * 4);
    LAS float* dump = ybuf + 2 * TC * 64;
    const int p = tid & 255, ltt = p >> 4, cq = p & 15;
    const int jq4 = 4 * (lane & 15);
    for (int item = blockIdx.x; item < 256; item += gridDim.x) {
        const int bh = item & 63, rq = item >> 6, b = bh >> 4, h = bh & 15;
        const int ch = h * 64 + 4 * cq;
        const int myrow = 16 * rq + 4 * (w & 3) + (lane >> 4);
        __syncthreads();
        if (w >= 4) {
            const f32x4 mur = *(const f32x4*)(mu_rkv + ch), muk = *(const f32x4*)(mu_rkv + 1024 + ch), muv = *(const f32x4*)(mu_rkv + 2048 + ch),
                        kkc = *(const f32x4*)(k_k + ch), kac = *(const f32x4*)(k_a + ch), rkc = *(const f32x4*)(r_k + ch);
            ScanRegs A0, A1, B0, B1;
            { const size_t tok = (size_t)b * T + 2 * ltt; scan_issue(A0, PRKV, WLOG, ASIG, tok, ch, ltt > 0 ? 1 : 2); scan_issue(A1, PRKV, WLOG, ASIG, tok + 1, ch, 0);
              const float b0 = scan_prepare(A0, A0.qr, A0.qk, A0.qv, buf + (2 * ltt) * SPITCH, cq, mur, muk, muv, kkc, kac, rkc);
              const float b1 = scan_prepare(A1, A0.pr, A0.pk, A0.pv, buf + (2 * ltt + 1) * SPITCH, cq, mur, muk, muv, kkc, kac, rkc);
              if (rq == 0 && cq == 0) { BONUS[tok * 16 + h] = b0; BONUS[(tok + 1) * 16 + h] = b1; }
              scan_issue(A0, PRKV, WLOG, ASIG, tok + TC, ch, 1); scan_issue(A1, PRKV, WLOG, ASIG, tok + TC + 1, ch, 0);
              scan_issue(B0, PRKV, WLOG, ASIG, tok + 2 * TC, ch, 1); scan_issue(B1, PRKV, WLOG, ASIG, tok + 2 * TC + 1, ch, 0); }
            __syncthreads();
#define PROD_STEP(c, X0, X1) do { \
                const int cur = (c) & 1; \
                const size_t tokn = (size_t)b * T + ((c) + 1) * TC + 2 * ltt; \
                if ((c) > 0) { const LAS float* yb = ybuf + (cur ^ 1) * TC * 64; bf16_t* yd = Y + ((size_t)b * T + ((c) - 1) * TC + 2 * ltt) * 1024 + h * 64 + 16 * rq + cq; \
                               yd[0] = f2bf(ysum4(yb + (2 * ltt) * 64 + cq * 4)); yd[1024] = f2bf(ysum4(yb + (2 * ltt + 1) * 64 + cq * 4)); } \
                if ((c) + 1 < T / TC) { \
                    LAS float* nb = buf + (cur ^ 1) * TC * SPITCH; \
                    const float b0 = scan_prepare(X0, X0.qr, X0.qk, X0.qv, nb + (2 * ltt) * SPITCH, cq, mur, muk, muv, kkc, kac, rkc); \
                    const float b1 = scan_prepare(X1, X0.pr, X0.pk, X0.pv, nb + (2 * ltt + 1) * SPITCH, cq, mur, muk, muv, kkc, kac, rkc); \
                    if (rq == 0 && cq == 0) { BONUS[tokn * 16 + h] = b0; BONUS[(tokn + 1) * 16 + h] = b1; } \
                    if ((c) + 3 < T / TC) { scan_issue(X0, PRKV, WLOG, ASIG, tokn + 2 * TC, ch, 1); scan_issue(X1, PRKV, WLOG, ASIG, tokn + 2 * TC + 1, ch, 0); } \
                } \
                __syncthreads(); } while (0)
            for (int c = 0; c < T / TC; c += 2) { PROD_STEP(c, A0, A1); PROD_STEP(c + 1, B0, B1); }
#undef PROD_STEP
            { const LAS float* yb = ybuf + 1 * TC * 64; bf16_t* yd = Y + ((size_t)b * T + (T / TC - 1) * TC + 2 * ltt) * 1024 + h * 64 + 16 * rq + cq;
              yd[0] = f2bf(ysum4(yb + (2 * ltt) * 64 + cq * 4)); yd[1024] = f2bf(ysum4(yb + (2 * ltt + 1) * 64 + cq * 4)); }
        } else {
            f32x2 S01 = (f32x2){0.f, 0.f}, S23 = (f32x2){0.f, 0.f};
            const bool holds_y = (lane & 3) == 0;
            const float m0 = (lane & 15) == 0 ? 1.0f : 0.0f;
            __syncthreads();
            for (int c = 0; c < T / TC; ++c) {
                const int cur = c & 1;
                const LAS float* bt = buf + cur * TC * SPITCH;
                LAS float* yd = holds_y ? (ybuf + cur * TC * 64 + 4 * (4 * w + (lane >> 4)) + ((lane & 15) >> 2)) : (dump + lane);
                ScanOps o; scan_ld(o, bt, jq4, myrow);
#pragma unroll 8
                for (int tt = 0; tt < TC; ++tt) {
                    ScanOps n; scan_ld(n, bt + (tt + 1 < TC ? tt + 1 : tt) * SPITCH, jq4, myrow);
                    __builtin_amdgcn_sched_barrier(0);
                    f32x2 ta = S01 * o.al.lo, ty = S01 * o.wr.lo; ta = S23 * o.al.hi + ta; ty = S23 * o.wr.hi + ty;
                    float pa = ta.x + ta.y, py = ty.x + ty.y;
                    f32x2 kv01 = o.kv.lo * o.vi, kv23 = o.kv.hi * o.vi;
                    float vc = o.vi * o.cc.y;
                    asm volatile("" : "+v"(kv01), "+v"(kv23), "+v"(vc));
                    pa += dpp_f<0x121>(pa); py += dpp_f<0x121>(py); pa += dpp_f<0x122>(pa); py += dpp_f<0x122>(py);
                    pa += dpp_f<0x124>(pa); pa += dpp_f<0x128>(pa);
                    S01 = S01 * o.wv.lo + (o.be.lo * pa + kv01);
                    S23 = S23 * o.wv.hi + (o.be.hi * pa + kv23);
                    yd[tt * 64] = (pa * o.cc.x + vc) * m0 + py;
                    __builtin_amdgcn_sched_barrier(0);
                    o = n;
                }
                __syncthreads();
            }
        }
    }
}
struct P8bRow { u32x4 y0, y1, v0, v1, g0, g1; float bon; };
__device__ __forceinline__ void p8b_load(P8bRow& r, const bf16_t* Y, const bf16_t* PRKV, const bf16_t* GG, const float* BONUS, int row, int c0, int lane) {
    r.y0 = *(const u32x4*)(Y + (size_t)row * 1024 + c0); r.y1 = *(const u32x4*)(Y + (size_t)row * 1024 + c0 + 8);
    r.v0 = *(const u32x4*)(PRKV + (size_t)row * 3072 + 2048 + c0); r.v1 = *(const u32x4*)(PRKV + (size_t)row * 3072 + 2048 + c0 + 8);
    r.g0 = *(const u32x4*)(GG + (size_t)row * 1024 + c0); r.g1 = *(const u32x4*)(GG + (size_t)row * 1024 + c0 + 8);
    r.bon = BONUS[(size_t)row * 16 + (lane >> 2)];
}
__device__ __forceinline__ void unpack8(const u32x4 u, float (&f)[8]) { f[0] = lo_bf(u.x); f[1] = hi_bf(u.x); f[2] = lo_bf(u.y); f[3] = hi_bf(u.y); f[4] = lo_bf(u.z); f[5] = hi_bf(u.z); f[6] = lo_bf(u.w); f[7] = hi_bf(u.w); }
__device__ __forceinline__ void p8b_post(const Args& a) {
    const int lane = threadIdx.x & 63, wave = threadIdx.x >> 6;
    const bf16_t* PRKV = (const bf16_t*)(a.ws + WS_PRKV); bf16_t* Y = (bf16_t*)(a.ws + WS_Y); const float* BONUS = (const float*)(a.ws + WS_BONUS);
    const bf16_t* GG = (const bf16_t*)((const unsigned char*)a.out + OUT_GG);
    const float* muv = a.in[9] + 2048; const float* lnw = a.in[22]; const float* lnb = a.in[23];
    const int c0 = lane * 16;
    f32x4 mu[4], lw[4], lb[4];
#pragma unroll
    for (int i = 0; i < 4; ++i) { mu[i] = *(const f32x4*)(muv + c0 + 4 * i); lw[i] = *(const f32x4*)(lnw + c0 + 4 * i); lb[i] = *(const f32x4*)(lnb + c0 + 4 * i); }
    for (int base = (blockIdx.x * 8 + wave) * RPW; base < M; base += gridDim.x * 8 * RPW) {
        u32x4 p0 = (u32x4){0u, 0u, 0u, 0u}, p1 = (u32x4){0u, 0u, 0u, 0u};
        if ((base & (T - 1)) != 0) { p0 = *(const u32x4*)(PRKV + (size_t)(base - 1) * 3072 + 2048 + c0); p1 = *(const u32x4*)(PRKV + (size_t)(base - 1) * 3072 + 2048 + c0 + 8); }
        P8bRow r; p8b_load(r, Y, PRKV, GG, BONUS, base, c0, lane);
#pragma unroll 2
        for (int k = 0; k < RPW; ++k) {
            const int row = base + k, rn = (k + 1 < RPW) ? row + 1 : row;
            P8bRow n; p8b_load(n, Y, PRKV, GG, BONUS, rn, c0, lane);
            float y[16];
            { float t0[8], t1[8]; unpack8(r.y0, t0); unpack8(r.y1, t1);
#pragma unroll
              for (int j = 0; j < 8; ++j) { y[j] = t0[j]; y[8 + j] = t1[j]; } }
            float s = 0.f;
#pragma unroll
            for (int j = 0; j < 16; ++j) s += y[j];
            s += __shfl_xor(s, 1); s += __shfl_xor(s, 2);
            const float mean = s * (1.0f / 64.0f);
            float q = 0.f;
#pragma unroll
            for (int j = 0; j < 16; ++j) { y[j] -= mean; q += y[j] * y[j]; }
            q += __shfl_xor(q, 1); q += __shfl_xor(q, 2);
            const float rstd = rsqrtf(q * (1.0f / 64.0f) + 64e-5f);
#pragma unroll
            for (int hf = 0; hf < 2; ++hf) {
                float cur[8], prv[8], gv[8];
                unpack8(hf ? r.v1 : r.v0, cur); unpack8(hf ? p1 : p0, prv); unpack8(hf ? r.g1 : r.g0, gv);
                float o[8];
#pragma unroll
                for (int j = 0; j < 8; ++j) { const int jj = hf * 8 + j; const float v = cur[j] + (prv[j] - cur[j]) * mu[jj >> 2][jj & 3];
                                              o[j] = ((y[jj] * rstd) * lw[jj >> 2][jj & 3] + lb[jj >> 2][jj & 3] + r.bon * v) * gv[j]; }
                u32x4 wv; wv.x = cvt_pk_bf16(o[0], o[1]); wv.y = cvt_pk_bf16(o[2], o[3]); wv.z = cvt_pk_bf16(o[4], o[5]); wv.w = cvt_pk_bf16(o[6], o[7]);
                *(u32x4*)(Y + (size_t)row * 1024 + c0 + hf * 8) = wv;
            }
            p0 = r.v0; p1 = r.v1; r = n;
        }
    }
}

__global__ void __launch_bounds__(NTHR, 2) mega(Args a) {
    extern __shared__ __attribute__((aligned(16))) unsigned char lds_raw[];
    LAS unsigned char* lds = (LAS unsigned char*)lds_raw;
    cg::grid_group grid = cg::this_grid();
    unsigned char* ws = a.ws;
    volatile LAS unsigned* bst = (volatile LAS unsigned*)(lds + LDS_BYTES - 16);
    if (threadIdx.x == 0) { bst[0] = 0u; bst[1] = 0u; }
    __syncthreads();
    XcdBarrier bar = xcd_barrier_post((unsigned*)(ws + WS_BAR), bst);
    const int lo = a.ph_lo, hi = a.ph_hi;
#ifndef PHMASK
#define PHMASK 0x3ffff
#endif
#define IN(k) (((PHMASK >> (k)) & 1) && lo <= (k) && (k) < hi)
#define SYNC(k) do { if ((k) + 1 < hi) { if (lo < 0) grid.sync(); else xcd_barrier(bar); } } while (0)
    if (IN(0)) { p0_prologue(a, lds); SYNC(0); }
    if (IN(1)) { p1_prenorm(a); SYNC(1); }
    if (IN(2)) { Epi<EP_QKV> E{(bf16_t*)(ws + WS_QKVA), 4608, nullptr, nullptr, nullptr, nullptr, nullptr, nullptr};
                 run_gemm<EP_QKV>(lds, (const bf16_t*)(ws + WS_HB), (const bf16_t*)(ws + WS_WA), 4608, 1024, E); SYNC(2); }
    if (IN(3)) { p3_attention(a, lds); SYNC(3); }
    if (IN(4)) { p4_combine(a); }
    if (IN(5)) { Epi<EP_SPLIT> E{(bf16_t*)(ws + WS_PRKV), 3072, (bf16_t*)(ws + WS_P), nullptr, nullptr, nullptr, nullptr, nullptr};
                 run_gemm<EP_SPLIT>(lds, (const bf16_t*)(ws + WS_HB), (const bf16_t*)(ws + WS_WB), 3840, 1024, E); SYNC(5); }
    if (IN(6)) { p6_loramid(a); SYNC(6); }
    if (IN(7)) { Epi<EP_L2> E{(bf16_t*)(ws + WS_WLOG), 1024, (bf16_t*)((unsigned char*)a.out + OUT_ASIG), (bf16_t*)((unsigned char*)a.out + OUT_GG), nullptr, nullptr, a.in[11], a.in[14]};
                 run_gemm<EP_L2>(lds, (const bf16_t*)(ws + WS_A2), (const bf16_t*)(ws + WS_W2), 3072, 384, E); SYNC(7); }
    if (IN(8)) { p8_scan(a, lds); SYNC(8); }
    if (IN(9)) { p8b_post(a); }
    if (IN(10)) { Epi<EP_SIG> E{(bf16_t*)((unsigned char*)a.out + OUT_ASIG), 1024, (bf16_t*)(ws + WS_WLOG), nullptr, nullptr, nullptr, nullptr, nullptr};
                  run_gemm<EP_SIG>(lds, (const bf16_t*)(ws + WS_HB), (const bf16_t*)(ws + WS_WC), 2048, 1024, E); SYNC(10); }
    if (IN(11)) { Epi<EP_MULG> E{(bf16_t*)(ws + WS_T1), 1024, nullptr, nullptr, (const bf16_t*)((const unsigned char*)a.out + OUT_ASIG), nullptr, nullptr, nullptr};
                  run_gemm<EP_MULG>(lds, (const bf16_t*)(ws + WS_Y), (const bf16_t*)(ws + WS_WOR), 1024, 1024, E); }
    if (IN(12)) { Epi<EP_MIX> E{(bf16_t*)(ws + WS_MIXIN), 1024, nullptr, nullptr, (const bf16_t*)(ws + WS_WLOG), (const bf16_t*)(ws + WS_T1), nullptr, nullptr};
                  run_gemm<EP_MIX>(lds, (const bf16_t*)(ws + WS_OATT), (const bf16_t*)(ws + WS_WOA), 1024, 512, E); SYNC(12); }
    if (IN(13)) { Epi<EP_PLAIN> E{(bf16_t*)(ws + WS_MIXED), 1024, nullptr, nullptr, nullptr, nullptr, nullptr, nullptr};
                  run_gemm<EP_PLAIN>(lds, (const bf16_t*)(ws + WS_MIXIN), (const bf16_t*)(ws + WS_WOUT), 1024, 1024, E); SYNC(13); }
    if (IN(14)) { p13_mid(a); SYNC(14); }
    if (IN(15)) { Epi<EP_SWIGLU> E{(bf16_t*)(ws + WS_U), 2816, nullptr, nullptr, nullptr, nullptr, nullptr, nullptr};
                  run_gemm<EP_SWIGLU>(lds, (const bf16_t*)(ws + WS_HB), (const bf16_t*)(ws + WS_WFI), 5632, 1024, E); SYNC(15); }
    if (IN(16)) { Epi<EP_PLAIN> E{(bf16_t*)(ws + WS_Y2), 1024, nullptr, nullptr, nullptr, nullptr, nullptr, nullptr};
                  run_gemm<EP_PLAIN>(lds, (const bf16_t*)(ws + WS_U), (const bf16_t*)(ws + WS_WFO), 1024, 2816, E); SYNC(16); }
    if (IN(17)) { p16_final(a); }
#undef IN
#undef SYNC
}

#ifndef MK_MULTI
#define MK_MULTI 0
#endif
extern "C" void kernel_launch(void* const* d_in, const int* in_sizes, int n_in, void* d_out, int out_size, void* d_ws, size_t ws_size, hipStream_t stream) {
    static int grid = 0;
    if (grid == 0) {
        if (n_in != 29 || out_size != M * D || ws_size < WS_END) { fprintf(stderr, "kernel_launch: unexpected problem shape (n_in %d out %d ws %zu)\n", n_in, out_size, ws_size); grid = -1; return; }
        int dev = 0, cus = 0, per_cu = 0;
        hipGetDevice(&dev);
        hipDeviceGetAttribute(&cus, hipDeviceAttributeMultiprocessorCount, dev);
        hipFuncSetAttribute((const void*)mega, hipFuncAttributeMaxDynamicSharedMemorySize, LDS_BYTES);
        hipOccupancyMaxActiveBlocksPerMultiprocessor(&per_cu, (const void*)mega, NTHR, LDS_BYTES);
        if (per_cu < 1) per_cu = 1;
        grid = cus * per_cu;
        (void)hipGetLastError();
    }
    if (grid < 0) return;
    Args a{};
    for (int i = 0; i < 29; ++i) a.in[i] = (const float*)d_in[i];
    a.out = (float*)d_out; a.ws = (unsigned char*)d_ws;
#if MK_MULTI
    for (int ph = 0; ph < NPHASE; ++ph) { a.ph_lo = ph; a.ph_hi = ph + 1; hipLaunchKernelGGL(mega, dim3(grid), dim3(NTHR), LDS_BYTES, stream, a); }
#else
    a.ph_lo = 0; a.ph_hi = NPHASE;
    if (hipMemsetAsync((unsigned char*)d_ws + WS_BAR, 0, XCD_BAR_WORDS * 4, stream) != hipSuccess) { fprintf(stderr, "kernel_launch: memset of the barrier words failed\n"); return; }
    void* args[] = {&a};
    hipError_t e = hipLaunchCooperativeKernel((const void*)mega, dim3(grid), dim3(NTHR), args, LDS_BYTES, stream);
    if (e != hipSuccess) fprintf(stderr, "cooperative launch failed: %s (grid %d)\n", hipGetErrorString(e), grid);
#endif
}
```

```cpp
#include <hip/hip_runtime.h>
#include <hip/hip_cooperative_groups.h>
#include <cstdio>
#include <cstdint>
namespace cg = cooperative_groups;
namespace pg8 {
#define PG8_LAS __attribute__((address_space(3)))
typedef unsigned short bf16_t;
typedef short bf16x8 __attribute__((ext_vector_type(8)));
typedef float f32x4 __attribute__((ext_vector_type(4)));
typedef unsigned u32x4 __attribute__((ext_vector_type(4)));
constexpr int BM = 256, BK = 64, HALF = 128, HTB = HALF * BK * 2  , STAGE_BYTES = 8 * HTB, NXCD = 8, WGM = 8;

__host__ __device__ __forceinline__ int lds_byte(int r, int c) { const int st = (r >> 4) * 2 + (c >> 5), rr = r & 15, cc = c & 31, ob = rr * 64 + cc * 2; return st * 1024 + (ob ^ (((ob >> 9) & 1) << 5)); }
__host__ __device__ __forceinline__ void stage_rc(int b, int& R, int& C) { const int st = b / 1024, sb = b % 1024, swz = sb ^ (((sb >> 9) & 1) << 5); R = (st >> 1) * 16 + swz / 64; C = (st & 1) * 32 + (swz % 64) / 2; }
__host__ __device__ __forceinline__ int perm32(int rho) { const int n = rho >> 4, i = rho & 15; return 8 * (i >> 2) + 4 * n + (i & 3); }

struct Unit { int pm, pn; };
struct Gemm { const bf16_t* A; const bf16_t* Bt; int M, N, K; };

struct StaticOrder {
    int nM, nN, nwg, G, c;
    __host__ __device__ void init(int M, int N, int G_, int c_) { nM = M / BM; nN = N / BM; nwg = nM * nN; G = G_; c = c_; }
    __host__ __device__ bool next(int i, Unit& u) const {
        const long L = (long)i * G + c; if (L >= nwg) return false;
        int wgid = (int)L; { const int q = nwg / NXCD, r = nwg % NXCD, xcd = wgid % NXCD, off = wgid / NXCD; wgid = (xcd < r ? xcd * (q + 1) : r * (q + 1) + (xcd - r) * q) + off; }
        const int nig = WGM * nN, gid = wgid / nig, fm = gid * WGM, gsz = (nM - fm) < WGM ? (nM - fm) : WGM;
        u.pm = fm + ((wgid % nig) % gsz); u.pn = (wgid % nig) / gsz; return true;
    }
    __device__ __forceinline__ void a_ready(const Unit&) const {}
    __device__ __forceinline__ void done(const Unit&) const {}
};
__device__ __forceinline__ unsigned cvt_pk_bf16(float lo, float hi) { unsigned r; asm volatile("v_cvt_pk_bf16_f32 %0, %1, %2" : "=v"(r) : "v"(lo), "v"(hi)); return r; }
template <class Epi, class Sched, bool ALIGN_EPI = false, bool SP2 = false>
__device__ __forceinline__ void gemm_phase(PG8_LAS unsigned char* lds, const Gemm g, const Sched& S, const Epi& E) {
    const int tid = threadIdx.x, wid = __builtin_amdgcn_readfirstlane(tid >> 6), lane = tid & 63, wr = wid >> 2, wc = wid & 3, fr = lane & 15, fq = lane >> 4;
    const int K = g.K, nt = K / BK;
    unsigned voffA[2], voffB[2];
#pragma unroll
    for (int i = 0; i < 2; ++i) { int R, C; stage_rc(tid * 16 + i * 8192, R, C); const int Rb = Epi::PERM ? ((R & ~31) + perm32(R & 31)) : R;
        voffA[i] = (unsigned)(R * K + C) * 2u; voffB[i] = (unsigned)(Rb * K + C) * 2u; }
    const size_t kstep = (size_t)(BK * 2);
    const size_t hstep = (size_t)HALF * K * 2;
    const size_t tstep = 2 * hstep;
    const unsigned ldsw = (unsigned)wid * 1024u;
    const int aoff = lds_byte(wr * 64 + fr, fq * 8), boff = lds_byte(wc * 32 + fr, fq * 8);
#define PG8_SA(b, h) (((b) * 2 + (h)) * HTB)
#define PG8_SB(b, h) ((4 + (b) * 2 + (h)) * HTB)
#define PG8_STAGE(bufoff, gbase, voff) do { _Pragma("unroll") for (int _i = 0; _i < 2; ++_i) \
        __builtin_amdgcn_global_load_lds((const unsigned*)((const char*)(gbase) + (voff)[_i]), (PG8_LAS unsigned*)(lds + (bufoff) + ldsw + _i * 8192), 16, 0, 0); } while (0)
#define PG8_LDA(dst, b, h) do { _Pragma("unroll") for (int m = 0; m < 4; ++m) _Pragma("unroll") for (int k = 0; k < 2; ++k) dst[m][k] = *(const PG8_LAS bf16x8*)(lds + PG8_SA(b, h) + aoff + m * 2048 + k * 1024); } while (0)
#define PG8_LDB(dst, b, h) do { _Pragma("unroll") for (int n = 0; n < 2; ++n) _Pragma("unroll") for (int k = 0; k < 2; ++k) dst[n][k] = *(const PG8_LAS bf16x8*)(lds + PG8_SB(b, h) + boff + n * 2048 + k * 1024); } while (0)
#define PG8_MMA(ai, bj, At, Bt) do { __builtin_amdgcn_s_setprio(1); _Pragma("unroll") for (int m = 0; m < 4; ++m) _Pragma("unroll") for (int n = 0; n < 2; ++n) _Pragma("unroll") for (int k = 0; k < 2; ++k) \
        acc[ai][bj][m][n] = __builtin_amdgcn_mfma_f32_16x16x32_bf16(Bt[n][k], At[m][k], acc[ai][bj][m][n], 0, 0, 0); __builtin_amdgcn_s_setprio(0); } while (0)
#define PG8_WAIT_V(n) asm volatile("s_waitcnt vmcnt(" #n ")" ::: "memory")
#define PG8_WAIT_L(n) asm volatile("s_waitcnt lgkmcnt(" #n ")" ::: "memory")
#define PG8_BAR __builtin_amdgcn_s_barrier()
#define PG8_SCHED __builtin_amdgcn_sched_barrier(0)
    Unit cur, nxt; int ui = 0;
    if (!S.next(0, cur)) return;
    f32x4 acc[2][2][4][2];
#pragma unroll
    for (int a = 0; a < 2; ++a)
#pragma unroll
        for (int b = 0; b < 2; ++b)
#pragma unroll
            for (int m = 0; m < 4; ++m)
#pragma unroll
                for (int n = 0; n < 2; ++n) acc[a][b][m][n] = (f32x4){0.f, 0.f, 0.f, 0.f};
    bf16x8 At[4][2], B0[2][2], B1[2][2];
    const char* cA = (const char*)g.A + (size_t)cur.pm * tstep; const char* cB = (const char*)g.Bt + (size_t)cur.pn * tstep;
    S.a_ready(cur);
    if constexpr (SP2) {
        PG8_STAGE(PG8_SB(0, 0), cB, voffB); PG8_STAGE(PG8_SB(0, 1), cB + hstep, voffB); PG8_STAGE(PG8_SA(0, 0), cA, voffA); PG8_STAGE(PG8_SA(0, 1), cA + hstep, voffA);
        if (wr == 1) PG8_BAR;
        PG8_WAIT_V(2); PG8_BAR;
        PG8_STAGE(PG8_SB(1, 0), cB + kstep, voffB); PG8_STAGE(PG8_SA(1, 0), cA + kstep, voffA); PG8_STAGE(PG8_SB(1, 1), cB + hstep + kstep, voffB);
        PG8_WAIT_V(6); PG8_BAR;
    } else {
        PG8_STAGE(PG8_SB(0, 0), cB, voffB); PG8_STAGE(PG8_SA(0, 0), cA, voffA); PG8_STAGE(PG8_SB(0, 1), cB + hstep, voffB); PG8_STAGE(PG8_SA(0, 1), cA + hstep, voffA);
        if (wr == 1) PG8_BAR;
        PG8_WAIT_V(4); PG8_BAR;
        PG8_STAGE(PG8_SB(1, 0), cB + kstep, voffB); PG8_STAGE(PG8_SA(1, 0), cA + kstep, voffA); PG8_STAGE(PG8_SB(1, 1), cB + hstep + kstep, voffB);
        PG8_WAIT_V(6); PG8_BAR;
    }
    for (;;) {
        const bool has_next = S.next(ui + 1, nxt);
        const char* nA = has_next ? (const char*)g.A + (size_t)nxt.pm * tstep : cA; const char* nB = has_next ? (const char*)g.Bt + (size_t)nxt.pn * tstep : cB;
#pragma nounroll
        for (int t = 0; t < nt; t += 2) {
            const bool last = (t == nt - 2);
            const char* a1 = cA + (size_t)(t + 1) * kstep;
            const char* a2 = last ? nA : cA + (size_t)(t + 2) * kstep; const char* b2 = last ? nB : cB + (size_t)(t + 2) * kstep;
            const char* a3 = a2 + kstep; const char* b3 = b2 + kstep;
            if (last && has_next) S.a_ready(nxt);
            if constexpr (SP2) {
            PG8_LDB(B0, 0, 0); PG8_LDB(B1, 0, 1); PG8_SCHED; PG8_LDA(At, 0, 0); PG8_STAGE(PG8_SA(1, 1), a1 + hstep, voffA);
            PG8_WAIT_V(8); PG8_WAIT_L(0); PG8_BAR; PG8_MMA(0, 0, At, B0); PG8_MMA(0, 1, At, B1); PG8_BAR; PG8_SCHED;
            PG8_LDA(At, 0, 1); PG8_STAGE(PG8_SB(0, 0), b2, voffB); PG8_STAGE(PG8_SB(0, 1), b2 + hstep, voffB); PG8_STAGE(PG8_SA(0, 0), a2, voffA);
            PG8_WAIT_V(8); PG8_WAIT_L(0); PG8_BAR; PG8_MMA(1, 0, At, B0); PG8_MMA(1, 1, At, B1); PG8_BAR; PG8_SCHED;
            PG8_LDB(B0, 1, 0); PG8_LDB(B1, 1, 1); PG8_SCHED; PG8_LDA(At, 1, 0); PG8_STAGE(PG8_SA(0, 1), a2 + hstep, voffA);
            PG8_WAIT_V(8); PG8_WAIT_L(0); PG8_BAR; PG8_MMA(0, 0, At, B0); PG8_MMA(0, 1, At, B1); PG8_BAR; PG8_SCHED;
            PG8_LDA(At, 1, 1); PG8_STAGE(PG8_SB(1, 0), b3, voffB); PG8_STAGE(PG8_SB(1, 1), b3 + hstep, voffB); PG8_STAGE(PG8_SA(1, 0), a3, voffA);
            PG8_WAIT_V(8); PG8_WAIT_L(0); PG8_BAR; PG8_MMA(1, 0, At, B0); PG8_MMA(1, 1, At, B1); PG8_BAR; PG8_SCHED;
            } else {
            PG8_LDB(B0, 0, 0); PG8_SCHED; PG8_LDA(At, 0, 0); PG8_STAGE(PG8_SA(1, 1), a1 + hstep, voffA);
            PG8_WAIT_L(8); PG8_BAR; PG8_WAIT_L(0); PG8_MMA(0, 0, At, B0); PG8_BAR; PG8_SCHED;
            PG8_LDB(B1, 0, 1); PG8_STAGE(PG8_SB(0, 0), b2, voffB);
            PG8_BAR; PG8_WAIT_L(0); PG8_MMA(0, 1, At, B1); PG8_BAR;
            PG8_LDA(At, 0, 1); PG8_STAGE(PG8_SA(0, 0), a2, voffA);
            PG8_BAR; PG8_WAIT_L(0); PG8_MMA(1, 0, At, B0); PG8_BAR; PG8_SCHED;
            PG8_STAGE(PG8_SB(0, 1), b2 + hstep, voffB);
            PG8_WAIT_V(6); PG8_BAR; PG8_MMA(1, 1, At, B1); PG8_BAR;
            PG8_LDB(B0, 1, 0); PG8_SCHED; PG8_LDA(At, 1, 0); PG8_STAGE(PG8_SA(0, 1), a2 + hstep, voffA);
            PG8_WAIT_L(8); PG8_BAR; PG8_WAIT_L(0); PG8_MMA(0, 0, At, B0); PG8_BAR; PG8_SCHED;
            PG8_LDB(B1, 1, 1); PG8_STAGE(PG8_SB(1, 0), b3, voffB);
            PG8_BAR; PG8_WAIT_L(0); PG8_MMA(0, 1, At, B1); PG8_BAR;
            PG8_LDA(At, 1, 1); PG8_STAGE(PG8_SA(1, 0), a3, voffA);
            PG8_BAR; PG8_WAIT_L(0); PG8_MMA(1, 0, At, B0); PG8_BAR; PG8_SCHED;
            PG8_STAGE(PG8_SB(1, 1), b3 + hstep, voffB);
            PG8_WAIT_V(6); PG8_BAR; PG8_MMA(1, 1, At, B1); PG8_BAR;
            }
        }
        if constexpr (ALIGN_EPI) { if (wr == 0) PG8_BAR; }
        if constexpr (!Epi::AFTER_DRAIN) { E(acc, cur, wr, wc, fr, fq); S.done(cur); }
        if (!has_next) break;
#pragma unroll
        for (int a = 0; a < 2; ++a)
#pragma unroll
            for (int b = 0; b < 2; ++b)
#pragma unroll
                for (int m = 0; m < 4; ++m)
#pragma unroll
                    for (int n = 0; n < 2; ++n) acc[a][b][m][n] = (f32x4){0.f, 0.f, 0.f, 0.f};
        cur = nxt; cA = nA; cB = nB; ++ui;
        if constexpr (ALIGN_EPI) { if (wr == 1) PG8_BAR; }
    }
    PG8_WAIT_V(0);
    if constexpr (!ALIGN_EPI) { if (wr == 0) PG8_BAR; }
    PG8_BAR;
    if constexpr (Epi::AFTER_DRAIN) { E.fused(acc, cur, wr, wc, fr, fq, lds, wid, lane); S.done(cur); }
#undef PG8_SA
#undef PG8_SB
#undef PG8_STAGE
#undef PG8_LDA
#undef PG8_LDB
#undef PG8_MMA
#undef PG8_WAIT_V
#undef PG8_WAIT_L
#undef PG8_BAR
#undef PG8_SCHED
}
}

typedef unsigned short bf16_t;
using pg8::f32x4; using pg8::bf16x8; using pg8::u32x4; using pg8::cvt_pk_bf16;
typedef short s16x4 __attribute__((ext_vector_type(4)));
typedef unsigned u32x2 __attribute__((ext_vector_type(2)));
#define LAS __attribute__((address_space(3)))
constexpr int NB = 4, T = 8192, D = 1024, M = NB * T, NTHR = 512;
constexpr size_t MiB = 1u << 20;
constexpr size_t WS_MOD = 0, WS_BAR = 512 * 1024, WS_BONUS = 1 * MiB, WS_WA = 3 * MiB, WS_WB = 12 * MiB, WS_WC = 20 * MiB, WS_W2 = 24 * MiB, WS_WOR = 27 * MiB, WS_WOA = 29 * MiB,
                 WS_WOUT = 30 * MiB, WS_WFI = 32 * MiB, WS_WFO = 43 * MiB;
constexpr size_t WS_HB = 50 * MiB, WS_QKVA = 114 * MiB, WS_OATT = 442 * MiB;
constexpr size_t WS_PRKV = 114 * MiB, WS_P = 306 * MiB, WS_A2 = 354 * MiB, WS_WLOG = 378 * MiB, WS_Y = 306 * MiB;
constexpr size_t WS_T1 = 242 * MiB, WS_MIXIN = 114 * MiB, WS_MIXED = 378 * MiB;
constexpr size_t WS_U = 114 * MiB, WS_Y2 = 290 * MiB, WS_END = 512 * MiB;
constexpr size_t OUT_OG = 0, OUT_LSE = 96 * MiB, OUT_ASIG = 0, OUT_GG = 64 * MiB;
constexpr int LDS_BYTES = 147456;
constexpr int NPHASE = 18;

struct Args { const float* in[29]; float* out; unsigned char* ws; int ph_lo, ph_hi; };

__device__ __forceinline__ float bf2f(bf16_t v) { return __uint_as_float(((unsigned)v) << 16); }
__device__ __forceinline__ bf16_t f2bf(float f) { unsigned u = __float_as_uint(f); u += 0x7FFFu + ((u >> 16) & 1u); return (bf16_t)(u >> 16); }
__device__ __forceinline__ float lo_bf(unsigned u) { return __uint_as_float(u << 16); }
__device__ __forceinline__ float hi_bf(unsigned u) { return __uint_as_float(u & 0xffff0000u); }
__device__ __forceinline__ float sigmoidf_(float x) { return __builtin_amdgcn_rcpf(1.0f + __expf(-x)); }
__device__ __forceinline__ float wave_sum(float v) {
#pragma unroll
    for (int o = 32; o >= 1; o >>= 1) v += __shfl_xor(v, o);
    return v;
}
__device__ __forceinline__ unsigned pk_f16(float a, float b) {
    const _Float16 ha = (_Float16)a, hb = (_Float16)b;
    return (unsigned)__builtin_bit_cast(unsigned short, ha) | ((unsigned)__builtin_bit_cast(unsigned short, hb) << 16);
}
__device__ __forceinline__ float f16_to_f(unsigned short h) { return (float)__builtin_bit_cast(_Float16, h); }

enum { EP_PLAIN = 0, EP_SPLIT = 1, EP_L2W = 2, EP_SIG = 3, EP_MULG = 4, EP_MIX = 5, EP_SWIGLU = 6, EP_L2A = 7, EP_L2 = 8, EP_QKV = 9 };
template <int MODE> struct Epi {
    static constexpr bool PERM = true, AFTER_DRAIN = false;
    bf16_t* O; int ldc; bf16_t* O2; bf16_t* O3; const bf16_t* G; const bf16_t* G2; const float* v0; const float* v1;
    __device__ __forceinline__ void operator()(const f32x4 (&acc)[2][2][4][2], const pg8::Unit& u, int wr, int wc, int fr, int fq) const {
        const int row0 = u.pm * 256 + wr * 64 + fr, cin = wc * 32 + 8 * fq;
#pragma unroll
        for (int ai = 0; ai < 2; ++ai)
#pragma unroll
            for (int m = 0; m < 4; ++m) {
                const size_t row = (size_t)(row0 + ai * 128 + m * 16);
                if constexpr (MODE == EP_SWIGLU) {
                    const f32x4 g0 = acc[ai][0][m][0], g1 = acc[ai][0][m][1], u0 = acc[ai][1][m][0], u1 = acc[ai][1][m][1];
                    float r[8];
#pragma unroll
                    for (int j = 0; j < 4; ++j) { r[j] = g0[j] * sigmoidf_(g0[j]) * u0[j]; r[4 + j] = g1[j] * sigmoidf_(g1[j]) * u1[j]; }
                    u32x4 w; w.x = cvt_pk_bf16(r[0], r[1]); w.y = cvt_pk_bf16(r[2], r[3]); w.z = cvt_pk_bf16(r[4], r[5]); w.w = cvt_pk_bf16(r[6], r[7]);
                    *(u32x4*)(O + row * ldc + u.pn * 128 + cin) = w;
                } else {
#pragma unroll
                    for (int bj = 0; bj < 2; ++bj) {
                        const int col = u.pn * 256 + bj * 128 + cin;
                        const f32x4 a0 = acc[ai][bj][m][0], a1 = acc[ai][bj][m][1];
                        float r[8] = {a0[0], a0[1], a0[2], a0[3], a1[0], a1[1], a1[2], a1[3]};
                        bf16_t* dst = O + row * ldc + col;
                        if constexpr (MODE == EP_SPLIT) { if (col >= 3072) dst = O2 + row * 768 + (col - 3072); }
                        if constexpr (MODE == EP_QKV) {
                            const int sg = u.pn >> 1, g = sg % 3, hh = (u.pn & 1) * 4 + ((bj * 128 + cin) >> 6), dd = cin & 63;
                            const int bb = (int)(row >> 13), t = (int)row & (T - 1), dsh = 2 * g, r = t & ((1 << dsh) - 1), uu = t >> dsh;
                            dst = O + ((((size_t)(sg * 8 + hh) * 4 + bb) * T + (size_t)r * (T >> dsh) + uu) << 6) + dd;
                        }
                        if constexpr (MODE == EP_SIG) {
#pragma unroll
                            for (int j = 0; j < 8; ++j) r[j] = sigmoidf_(r[j]);
                            dst = (col < 1024) ? (O + row * 1024 + col) : (O2 + row * 1024 + (col - 1024));
                        }
                        if constexpr (MODE == EP_MULG) {
                            const u32x4 gv = *(const u32x4*)(G + row * 1024 + col);
                            r[0] *= lo_bf(gv.x); r[1] *= hi_bf(gv.x); r[2] *= lo_bf(gv.y); r[3] *= hi_bf(gv.y); r[4] *= lo_bf(gv.z); r[5] *= hi_bf(gv.z); r[6] *= lo_bf(gv.w); r[7] *= hi_bf(gv.w);
                        }
                        if constexpr (MODE == EP_MIX) {
                            const u32x4 gv = *(const u32x4*)(G + row * 1024 + col);
                            const u32x4 tv = *(const u32x4*)(G2 + row * 1024 + col);
                            r[0] = lo_bf(tv.x) + r[0] * lo_bf(gv.x); r[1] = hi_bf(tv.x) + r[1] * hi_bf(gv.x); r[2] = lo_bf(tv.y) + r[2] * lo_bf(gv.y); r[3] = hi_bf(tv.y) + r[3] * hi_bf(gv.y);
                            r[4] = lo_bf(tv.z) + r[4] * lo_bf(gv.z); r[5] = hi_bf(tv.z) + r[5] * hi_bf(gv.z); r[6] = lo_bf(tv.w) + r[6] * lo_bf(gv.w); r[7] = hi_bf(tv.w) + r[7] * hi_bf(gv.w);
                        }
                        if constexpr (MODE == EP_L2) {
                            const int region = u.pn >> 2, cc = col - 1024 * region;
                            if (region == 0) {
                                const f32x4 b0 = *(const f32x4*)(v0 + cc), b1 = *(const f32x4*)(v0 + cc + 4);
                                const float z[8] = {b0[0], b0[1], b0[2], b0[3], b1[0], b1[1], b1[2], b1[3]};
#pragma unroll
                                for (int j = 0; j < 8; ++j) r[j] = 1.0f - __expf(-0.6065306597126334f * sigmoidf_(z[j] + r[j]));
                                u32x4 w; w.x = pk_f16(r[0], r[1]); w.y = pk_f16(r[2], r[3]); w.z = pk_f16(r[4], r[5]); w.w = pk_f16(r[6], r[7]);
                                *(u32x4*)(O + row * 1024 + cc) = w;
                                continue;
                            } else if (region == 1) {
                                const f32x4 b0 = *(const f32x4*)(v1 + cc), b1 = *(const f32x4*)(v1 + cc + 4);
                                const float z[8] = {b0[0], b0[1], b0[2], b0[3], b1[0], b1[1], b1[2], b1[3]};
#pragma unroll
                                for (int j = 0; j < 8; ++j) r[j] = sigmoidf_(z[j] + r[j]);
                                dst = O2 + row * 1024 + cc;
                            } else dst = O3 + row * 1024 + cc;
                        }
                        if constexpr (MODE == EP_L2W) {
                            const f32x4 b0 = *(const f32x4*)(v0 + col), b1 = *(const f32x4*)(v0 + col + 4);
                            const float z[8] = {b0[0], b0[1], b0[2], b0[3], b1[0], b1[1], b1[2], b1[3]};
#pragma unroll
                            for (int j = 0; j < 8; ++j) r[j] = 1.0f - __expf(-0.6065306597126334f * sigmoidf_(z[j] + r[j]));
                            u32x4 w; w.x = pk_f16(r[0], r[1]); w.y = pk_f16(r[2], r[3]); w.z = pk_f16(r[4], r[5]); w.w = pk_f16(r[6], r[7]);
                            *(u32x4*)dst = w;
                            continue;
                        }
                        if constexpr (MODE == EP_L2A) {
                            const f32x4 b0 = *(const f32x4*)(v0 + col), b1 = *(const f32x4*)(v0 + col + 4);
                            const float z[8] = {b0[0], b0[1], b0[2], b0[3], b1[0], b1[1], b1[2], b1[3]};
#pragma unroll
                            for (int j = 0; j < 8; ++j) r[j] = sigmoidf_(z[j] + r[j]);
                        }
                        u32x4 w; w.x = cvt_pk_bf16(r[0], r[1]); w.y = cvt_pk_bf16(r[2], r[3]); w.z = cvt_pk_bf16(r[4], r[5]); w.w = cvt_pk_bf16(r[6], r[7]);
                        *(u32x4*)dst = w;
                    }
                }
            }
    }
};
template <int MODE> __device__ __forceinline__ void run_gemm(LAS unsigned char* lds, const bf16_t* A, const bf16_t* Bt, int N, int K, const Epi<MODE>& E) {
    pg8::Gemm g{A, Bt, M, N, K}; pg8::StaticOrder S; S.init(M, N, (int)gridDim.x, (int)blockIdx.x);
    pg8::gemm_phase<Epi<MODE>, pg8::StaticOrder, true, true>(lds, g, S, E);
}

#define XB_TMO      128
#define XB_XCNT(j)  (256  + 64 * (j))
#define XB_XSUB(j)  (1280 + 64 * (j))
#define XB_XGEN(j)  (2304 + 64 * (j))
#define XB_TOP      3328
#define XB_TOPGEN   3392
#define XCD_BAR_WORDS 3456
#define XB_SPIN_CAP (1u << 18)

__device__ __forceinline__ unsigned xb_ld(unsigned* p)              { return __hip_atomic_load(p, __ATOMIC_RELAXED, __HIP_MEMORY_SCOPE_AGENT); }
__device__ __forceinline__ unsigned xb_add(unsigned* p, unsigned v) { return __hip_atomic_fetch_add(p, v, __ATOMIC_RELAXED, __HIP_MEMORY_SCOPE_AGENT); }
__device__ __forceinline__ unsigned xb_xcc_id() { return (unsigned)__builtin_amdgcn_s_getreg((3 << 11) | 20) & 0xFu; }
#define XB_SPIN(cond, bar) do { unsigned _sp = 0; while (cond) { __builtin_amdgcn_s_sleep(1); \
    if ((++_sp & 255u) == 0u) { if (xb_ld(&(bar)[XB_TMO])) break; if (_sp > XB_SPIN_CAP) { atomicAdd(&(bar)[XB_TMO], 1u); break; } } } } while (0)

struct XcdBarrier {
    unsigned* bar; unsigned x;
    volatile LAS unsigned* st;
};

__device__ __forceinline__ XcdBarrier xcd_barrier_post(unsigned* bar, volatile LAS unsigned* st) {
    XcdBarrier b; b.bar = bar; b.x = xb_xcc_id(); b.st = st;
    if (threadIdx.x == 0) (void)xb_add(&bar[XB_XCNT(b.x)], 1u);
    return b;
}
__device__ __forceinline__ void xcd_barrier_complete(unsigned* bar, unsigned x, unsigned& nloc, unsigned& nx) {
    const unsigned G = gridDim.x * gridDim.y * gridDim.z;
    unsigned sum, cnt, mine, sp = 0u;
    for (;;) {
        sum = 0u; cnt = 0u; mine = 0u;
#pragma unroll
        for (unsigned j = 0; j < 16; ++j) { const unsigned c = xb_ld(&bar[XB_XCNT(j)]); sum += c; cnt += (c > 0u) ? 1u : 0u; mine = (j == x) ? c : mine; }
        if (sum == G) break;
        __builtin_amdgcn_s_sleep(1);
        if ((++sp & 255u) == 0u) { if (xb_ld(&bar[XB_TMO])) break; if (sp > XB_SPIN_CAP) { atomicAdd(&bar[XB_TMO], 1u); break; } }
    }
    nloc = mine > 0u ? mine : 1u; nx = cnt > 0u ? cnt : 1u;
}

__device__ __forceinline__ void xcd_barrier(const XcdBarrier& b) {
    asm volatile("s_waitcnt vmcnt(0)" ::: "memory");
    __syncthreads();
    if (threadIdx.x == 0) {
        unsigned* bar = b.bar;
        __builtin_amdgcn_s_waitcnt(0);
        unsigned nloc = b.st[0], nx = b.st[1];
        if (nloc == 0u) { xcd_barrier_complete(bar, b.x, nloc, nx); b.st[0] = nloc; b.st[1] = nx; }
        const unsigned old = xb_add(&bar[XB_XSUB(b.x)], 1u);
        const unsigned gen = old / nloc;
        if (old + 1u == (gen + 1u) * nloc) {
            __builtin_amdgcn_fence(__ATOMIC_RELEASE, "agent");
            asm volatile("s_waitcnt vmcnt(0)" ::: "memory");
            const unsigned og = xb_add(&bar[XB_TOP], 1u);
            const unsigned tg = og / nx;
            if (og + 1u == (tg + 1u) * nx) xb_add(&bar[XB_TOPGEN], 1u);
            else XB_SPIN(xb_ld(&bar[XB_TOPGEN]) == tg, bar);
            __builtin_amdgcn_fence(__ATOMIC_ACQUIRE, "agent");
            xb_add(&bar[XB_XGEN(b.x)], 1u);
            asm volatile("s_waitcnt vmcnt(0)" ::: "memory");
        } else {
            XB_SPIN(xb_ld(&bar[XB_XGEN(b.x)]) == gen, bar);
            __builtin_amdgcn_fence(__ATOMIC_ACQUIRE, "agent");
            asm volatile("s_waitcnt vmcnt(0)" ::: "memory");
        }
    }
    __syncthreads();
}


constexpr int TRP = 129;
struct TrJob { const float* src; int ld, c0, ncols, K; bf16_t* dst; int ldd, drow0, dk0; const float* rs; int rsmode; float cscale; };
__device__ __forceinline__ void tile_load(const TrJob& j, int t, float (&v)[16]) {
    const int tid = threadIdx.x, cc = tid & 127, kb = tid >> 7;
    const int nct = (j.ncols + 127) >> 7, ct = t % nct, k0 = (t / nct) * 64;
    int nc = j.ncols - ct * 128; if (nc > 128) nc = 128;
    const float* s = j.src + j.c0 + ct * 128 + cc;
#pragma unroll
    for (int p = 0; p < 16; ++p) { const int kk = k0 + kb + 4 * p; v[p] = (kk < j.K && cc < nc) ? s[(size_t)kk * j.ld] : 0.f; }
    if (j.rs) {
#pragma unroll
        for (int p = 0; p < 16; ++p) { const int kk = k0 + kb + 4 * p; if (kk < j.K) { const float mu = j.rs[kk]; v[p] *= j.rsmode ? mu : (1.0f - mu); } }
    }
}
__device__ __forceinline__ void tile_finish(LAS float* tile, const TrJob& j, int t, const float (&v)[16]) {
    const int tid = threadIdx.x, cc = tid & 127, kb = tid >> 7;
    const int nct = (j.ncols + 127) >> 7, ct = t % nct, k0 = (t / nct) * 64;
    int nc = j.ncols - ct * 128; if (nc > 128) nc = 128;
    __syncthreads();
#pragma unroll
    for (int p = 0; p < 16; ++p) tile[(kb + 4 * p) * TRP + cc] = v[p] * j.cscale;
    __syncthreads();
    const int n = tid >> 2, ks = tid & 3;
    if (n < nc) {
#pragma unroll
        for (int hf = 0; hf < 2; ++hf) {
            const int kq = ks * 16 + hf * 8;
            if (k0 + kq < j.K) {
                float r[8];
#pragma unroll
                for (int q = 0; q < 8; ++q) r[q] = tile[(kq + q) * TRP + n];
                u32x4 w; w.x = cvt_pk_bf16(r[0], r[1]); w.y = cvt_pk_bf16(r[2], r[3]); w.z = cvt_pk_bf16(r[4], r[5]); w.w = cvt_pk_bf16(r[6], r[7]);
                *(u32x4*)(j.dst + (size_t)(j.drow0 + ct * 128 + n) * j.ldd + j.dk0 + k0 + kq) = w;
            }
        }
    }
}
constexpr int NTILES = 2760;
__device__ __forceinline__ void tile_decode(const Args& a, int g, TrJob& j, int& t) {
    unsigned char* ws = a.ws; const float* w_in = a.in[8]; const float* mu = a.in[10];
    bf16_t* WA = (bf16_t*)(ws + WS_WA); bf16_t* WB = (bf16_t*)(ws + WS_WB); bf16_t* W2 = (bf16_t*)(ws + WS_W2);
    const float QS = 0.125f * 1.4426950408889634f;
    if (g < 192) { j = TrJob{w_in, 9728, 3072, 1536, 1024, WA, 1024, 0, 0, nullptr, 0, QS}; t = g; return; } g -= 192;
    if (g < 384) { j = TrJob{w_in, 9728, 4608, 3072, 1024, WA, 1024, 1536, 0, nullptr, 0, 1.0f}; t = g; return; } g -= 384;
    if (g < 384) { j = TrJob{w_in, 9728, 0, 3072, 1024, WB, 1024, 0, 0, nullptr, 0, 1.0f}; t = g; return; } g -= 384;
    if (g < 16) { j = TrJob{a.in[12], 64, 0, 64, 1024, WB, 1024, 3072, 0, mu, 0, 1.0f}; t = g; return; } g -= 16;
    if (g < 16) { j = TrJob{a.in[15], 64, 0, 64, 1024, WB, 1024, 3136, 0, mu + 1024, 0, 1.0f}; t = g; return; } g -= 16;
    if (g < 32) { j = TrJob{a.in[17], 160, 0, 160, 1024, WB, 1024, 3200, 0, mu + 2048, 0, 1.0f}; t = g; return; } g -= 32;
    if (g < 16) { j = TrJob{a.in[12], 64, 0, 64, 1024, WB, 1024, 3360, 0, mu, 1, 1.0f}; t = g; return; } g -= 16;
    if (g < 16) { j = TrJob{a.in[15], 64, 0, 64, 1024, WB, 1024, 3424, 0, mu + 1024, 1, 1.0f}; t = g; return; } g -= 16;
    if (g < 32) { j = TrJob{a.in[17], 160, 0, 160, 1024, WB, 1024, 3488, 0, mu + 2048, 1, 1.0f}; t = g; return; } g -= 32;
    if (g < 256) { j = TrJob{w_in, 9728, 7680, 2048, 1024, (bf16_t*)(ws + WS_WC), 1024, 0, 0, nullptr, 0, 1.0f}; t = g; return; } g -= 256;
    if (g < 128) { j = TrJob{a.in[24], 1024, 0, 1024, 1024, (bf16_t*)(ws + WS_WOR), 1024, 0, 0, nullptr, 0, 1.0f}; t = g; return; } g -= 128;
    if (g < 64) { j = TrJob{a.in[25], 1024, 0, 1024, 512, (bf16_t*)(ws + WS_WOA), 512, 0, 0, nullptr, 0, 1.0f}; t = g; return; } g -= 64;
    if (g < 128) { j = TrJob{a.in[26], 1024, 0, 1024, 1024, (bf16_t*)(ws + WS_WOUT), 1024, 0, 0, nullptr, 0, 1.0f}; t = g; return; } g -= 128;
    if (g < 352) { j = TrJob{a.in[28], 1024, 0, 1024, 2816, (bf16_t*)(ws + WS_WFO), 2816, 0, 0, nullptr, 0, 1.0f}; t = g; return; } g -= 352;
    if (g < 704) { const int s = g >> 4, pn = s >> 1, bj = s & 1;
                   j = TrJob{a.in[27], 5632, bj * 2816 + pn * 128, 128, 1024, (bf16_t*)(ws + WS_WFI), 1024, pn * 256 + bj * 128, 0, nullptr, 0, 1.0f}; t = g & 15; return; } g -= 704;
    if (g < 8) { j = TrJob{a.in[13], 1024, 0, 1024, 64, W2, 384, 0, 0, nullptr, 0, 1.0f}; t = g; return; } g -= 8;
    if (g < 8) { j = TrJob{a.in[16], 1024, 0, 1024, 64, W2, 384, 1024, 64, nullptr, 0, 1.0f}; t = g; return; } g -= 8;
    j = TrJob{a.in[18], 1024, 0, 1024, 160, W2, 384, 2048, 128, nullptr, 0, 1.0f}; t = g;
}
__device__ __forceinline__ void p0_prologue(const Args& a, LAS unsigned char* lds) {
    LAS float* tile = (LAS float*)lds;
    unsigned char* ws = a.ws;
    const int tid = threadIdx.x, G = gridDim.x, bx = blockIdx.x;
    const float* w_in = a.in[8]; const float* mu_lora = a.in[10];
    bf16_t* WA = (bf16_t*)(ws + WS_WA); bf16_t* WB = (bf16_t*)(ws + WS_WB); bf16_t* WC = (bf16_t*)(ws + WS_WC); bf16_t* W2 = (bf16_t*)(ws + WS_W2);
    {
        const float* c = a.in[1]; const float* w_mod = a.in[2]; const float* b_mod = a.in[3];
        float* MOD = (float*)(ws + WS_MOD);
        LAS float* red = (LAS float*)lds;
        for (int cb = bx; cb < 256; cb += G) {
            const int col = tid % 24, kg = tid / 24;
            float s0 = 0.f, s1 = 0.f, s2 = 0.f, s3 = 0.f;
            if (kg < 21)
#pragma unroll 7
            for (int k = kg; k < 1024; k += 21) { const float w = w_mod[(size_t)k * 6144 + cb * 24 + col]; s0 += c[k] * w; s1 += c[1024 + k] * w; s2 += c[2048 + k] * w; s3 += c[3072 + k] * w; }
            __syncthreads();
            if (kg < 21) { red[(kg * 24 + col) * 4 + 0] = s0; red[(kg * 24 + col) * 4 + 1] = s1; red[(kg * 24 + col) * 4 + 2] = s2; red[(kg * 24 + col) * 4 + 3] = s3; }
            __syncthreads();
            if (tid < 96) { const int cc = tid % 24, b = tid / 24; float s = 0.f; for (int g = 0; g < 21; ++g) s += red[(g * 24 + cc) * 4 + b]; MOD[b * 6144 + cb * 24 + cc] = s + b_mod[cb * 24 + cc]; }
        }
        __syncthreads();
    }
    {
        int g = bx, t = 0, tn = 0; TrJob j{}, jn{}; float v[16], vn[16];
        if (g < NTILES) { tile_decode(a, g, j, t); tile_load(j, t, v); }
        while (g < NTILES) {
            const int gn = g + G;
            if (gn < NTILES) { tile_decode(a, gn, jn, tn); tile_load(jn, tn, vn); }
            tile_finish(tile, j, t, v);
            j = jn; t = tn; g = gn;
#pragma unroll
            for (int p2 = 0; p2 < 16; ++p2) v[p2] = vn[p2];
        }
    }
    for (int i = bx * NTHR + tid; i < 192 * 1024 / 8; i += G * NTHR) ((u32x4*)(WB + (size_t)3648 * 1024))[i] = (u32x4){0u, 0u, 0u, 0u};
    for (int i = bx * NTHR + tid; i < 1024 * 108; i += G * NTHR) {
        const int row = i / 108, c = i % 108;
        int n, k8;
        if (c < 40) { n = row; k8 = 8 + c; }
        else if (c < 80) { n = 1024 + row; k8 = (c - 40) < 8 ? (c - 40) : (c - 40) + 8; }
        else { n = 2048 + row; k8 = (c - 80) < 16 ? (c - 80) : (c - 80) + 20; }
        *(u32x4*)(W2 + (size_t)n * 384 + k8 * 8) = (u32x4){0u, 0u, 0u, 0u};
    }
}

constexpr int RPW = 16;
__device__ __forceinline__ void p1_prenorm(const Args& a) {
    const int lane = threadIdx.x & 63, wave = threadIdx.x >> 6;
    const float* x = a.in[0]; const float* gpre = a.in[4]; const float* MOD = (const float*)(a.ws + WS_MOD); bf16_t* HB = (bf16_t*)(a.ws + WS_HB);
    for (int base = (blockIdx.x * 8 + wave) * RPW; base < M; base += gridDim.x * 8 * RPW) {
        const float* mod = MOD + (base / T) * 6144;
        f32x4 g[4], sh[4], sc[4];
#pragma unroll
        for (int i = 0; i < 4; ++i) { const int c = i * 256 + lane * 4; g[i] = *(const f32x4*)(gpre + c); sh[i] = *(const f32x4*)(mod + c); sc[i] = *(const f32x4*)(mod + 1024 + c) + 1.0f; }
        f32x4 v[4];
#pragma unroll
        for (int i = 0; i < 4; ++i) v[i] = ((const f32x4*)(x + (size_t)base * D))[i * 64 + lane];
#pragma unroll 2
        for (int k = 0; k < RPW; ++k) {
            const int row = base + k, rn = (k + 1 < RPW) ? row + 1 : row;
            f32x4 vn[4];
#pragma unroll
            for (int i = 0; i < 4; ++i) vn[i] = ((const f32x4*)(x + (size_t)rn * D))[i * 64 + lane];
            float ss = 0.f;
#pragma unroll
            for (int i = 0; i < 4; ++i) ss += v[i][0] * v[i][0] + v[i][1] * v[i][1] + v[i][2] * v[i][2] + v[i][3] * v[i][3];
            ss = wave_sum(ss);
            const float rs = rsqrtf(ss * (1.0f / D) + 1e-6f);
#pragma unroll
            for (int i = 0; i < 4; ++i) {
                float r[4];
#pragma unroll
                for (int j = 0; j < 4; ++j) r[j] = (v[i][j] * rs * g[i][j]) * sc[i][j] + sh[i][j];
                u32x2 w; w.x = cvt_pk_bf16(r[0], r[1]); w.y = cvt_pk_bf16(r[2], r[3]);
                *(u32x2*)(HB + (size_t)row * D + i * 256 + lane * 4) = w;
            }
#pragma unroll
            for (int i = 0; i < 4; ++i) v[i] = vn[i];
        }
    }
}
__device__ __forceinline__ void p13_mid(const Args& a) {
    const int lane = threadIdx.x & 63, wave = threadIdx.x >> 6;
    const float* x = a.in[0]; const float* gpost = a.in[5]; const float* gpre2 = a.in[6]; const float* MOD = (const float*)(a.ws + WS_MOD);
    const bf16_t* MX = (const bf16_t*)(a.ws + WS_MIXED); bf16_t* HB = (bf16_t*)(a.ws + WS_HB); float* out = a.out;
    for (int base = (blockIdx.x * 8 + wave) * RPW; base < M; base += gridDim.x * 8 * RPW) {
        const float* mod = MOD + (base / T) * 6144;
        f32x4 gg[4], g2[4], sh[4], sc[4];
#pragma unroll
        for (int i = 0; i < 4; ++i) { const int c = i * 256 + lane * 4; gg[i] = *(const f32x4*)(gpost + c) * *(const f32x4*)(mod + 2048 + c); g2[i] = *(const f32x4*)(gpre2 + c);
                                      sh[i] = *(const f32x4*)(mod + 3072 + c); sc[i] = *(const f32x4*)(mod + 4096 + c) + 1.0f; }
        u32x2 m[4]; f32x4 xv[4];
#pragma unroll
        for (int i = 0; i < 4; ++i) { m[i] = *(const u32x2*)(MX + (size_t)base * D + i * 256 + lane * 4); xv[i] = *(const f32x4*)(x + (size_t)base * D + i * 256 + lane * 4); }
#pragma unroll 2
        for (int k = 0; k < RPW; ++k) {
            const int row = base + k, rn = (k + 1 < RPW) ? row + 1 : row;
            u32x2 mn[4]; f32x4 xn[4];
#pragma unroll
            for (int i = 0; i < 4; ++i) { mn[i] = *(const u32x2*)(MX + (size_t)rn * D + i * 256 + lane * 4); xn[i] = *(const f32x4*)(x + (size_t)rn * D + i * 256 + lane * 4); }
            f32x4 v[4]; float ss = 0.f;
#pragma unroll
            for (int i = 0; i < 4; ++i) { v[i] = (f32x4){lo_bf(m[i].x), hi_bf(m[i].x), lo_bf(m[i].y), hi_bf(m[i].y)}; ss += v[i][0] * v[i][0] + v[i][1] * v[i][1] + v[i][2] * v[i][2] + v[i][3] * v[i][3]; }
            ss = wave_sum(ss);
            const float rs = rsqrtf(ss * (1.0f / D) + 1e-6f);
            float ss2 = 0.f;
#pragma unroll
            for (int i = 0; i < 4; ++i) {
#pragma unroll
                for (int j = 0; j < 4; ++j) { v[i][j] = xv[i][j] + gg[i][j] * (v[i][j] * rs); ss2 += v[i][j] * v[i][j]; }
            }
            ss2 = wave_sum(ss2);
            const float rs2 = rsqrtf(ss2 * (1.0f / D) + 1e-6f);
#pragma unroll
            for (int i = 0; i < 4; ++i) {
                float r[4];
#pragma unroll
                for (int j = 0; j < 4; ++j) r[j] = (v[i][j] * rs2 * g2[i][j]) * sc[i][j] + sh[i][j];
                u32x2 w; w.x = cvt_pk_bf16(r[0], r[1]); w.y = cvt_pk_bf16(r[2], r[3]);
                *(u32x2*)(HB + (size_t)row * D + i * 256 + lane * 4) = w;
            }
#pragma unroll
            for (int i = 0; i < 4; ++i) { m[i] = mn[i]; xv[i] = xn[i]; }
        }
    }
}
__device__ __forceinline__ void p16_final(const Args& a) {
    const int lane = threadIdx.x & 63, wave = threadIdx.x >> 6;
    const float* x = a.in[0]; const float* gpm = a.in[5]; const float* gpost = a.in[7]; const float* MOD = (const float*)(a.ws + WS_MOD);
    const bf16_t* MX = (const bf16_t*)(a.ws + WS_MIXED); const bf16_t* Y2 = (const bf16_t*)(a.ws + WS_Y2); float* out = a.out;
    for (int base = (blockIdx.x * 8 + wave) * RPW; base < M; base += gridDim.x * 8 * RPW) {
        const float* mod = MOD + (base / T) * 6144;
        f32x4 gm[4], gg[4];
#pragma unroll
        for (int i = 0; i < 4; ++i) { const int c = i * 256 + lane * 4; gm[i] = *(const f32x4*)(gpm + c) * *(const f32x4*)(mod + 2048 + c); gg[i] = *(const f32x4*)(gpost + c) * *(const f32x4*)(mod + 5120 + c); }
        u32x2 m[4], y[4]; f32x4 xv[4];
#pragma unroll
        for (int i = 0; i < 4; ++i) { const size_t o = (size_t)base * D + i * 256 + lane * 4; m[i] = *(const u32x2*)(MX + o); y[i] = *(const u32x2*)(Y2 + o); xv[i] = *(const f32x4*)(x + o); }
#pragma unroll 2
        for (int k = 0; k < RPW; ++k) {
            const int row = base + k, rn = (k + 1 < RPW) ? row + 1 : row;
            u32x2 mn[4], yn[4]; f32x4 xn[4];
#pragma unroll
            for (int i = 0; i < 4; ++i) { const size_t o = (size_t)rn * D + i * 256 + lane * 4; mn[i] = *(const u32x2*)(MX + o); yn[i] = *(const u32x2*)(Y2 + o); xn[i] = *(const f32x4*)(x + o); }
            f32x4 vm[4], vy[4]; float s1 = 0.f, s2 = 0.f;
#pragma unroll
            for (int i = 0; i < 4; ++i) { vm[i] = (f32x4){lo_bf(m[i].x), hi_bf(m[i].x), lo_bf(m[i].y), hi_bf(m[i].y)}; vy[i] = (f32x4){lo_bf(y[i].x), hi_bf(y[i].x), lo_bf(y[i].y), hi_bf(y[i].y)};
                s1 += vm[i][0] * vm[i][0] + vm[i][1] * vm[i][1] + vm[i][2] * vm[i][2] + vm[i][3] * vm[i][3]; s2 += vy[i][0] * vy[i][0] + vy[i][1] * vy[i][1] + vy[i][2] * vy[i][2] + vy[i][3] * vy[i][3]; }
            s1 = wave_sum(s1); s2 = wave_sum(s2);
            const float r1 = rsqrtf(s1 * (1.0f / D) + 1e-6f), r2 = rsqrtf(s2 * (1.0f / D) + 1e-6f);
#pragma unroll
            for (int i = 0; i < 4; ++i) {
                f32x4 o;
#pragma unroll
                for (int j = 0; j < 4; ++j) { const float x1 = xv[i][j] + gm[i][j] * (vm[i][j] * r1); o[j] = x1 + gg[i][j] * (vy[i][j] * r2); }
                *(f32x4*)(out + (size_t)row * D + i * 256 + lane * 4) = o;
            }
#pragma unroll
            for (int i = 0; i < 4; ++i) { m[i] = mn[i]; y[i] = yn[i]; xv[i] = xn[i]; }
        }
    }
}
__device__ __forceinline__ void p6_loramid(const Args& a) {
    const bf16_t* P = (const bf16_t*)(a.ws + WS_P); bf16_t* A2 = (bf16_t*)(a.ws + WS_A2);
    for (int i = blockIdx.x * NTHR + threadIdx.x; i < M * 192; i += gridDim.x * NTHR) {
        const int tok = i / 192, c = (i % 192) * 2;
        float h0 = 0.f, h1 = 0.f;
        if (c < 288) {
            const unsigned cur = *(const unsigned*)(P + (size_t)tok * 768 + c);
            h0 = lo_bf(cur); h1 = hi_bf(cur);
            if ((tok & (T - 1)) != 0) { const unsigned prv = *(const unsigned*)(P + (size_t)(tok - 1) * 768 + 288 + c); h0 += lo_bf(prv); h1 += hi_bf(prv); }
            if (c < 64) { h0 = 1.0f - 2.0f * __builtin_amdgcn_rcpf(__expf(2.0f * h0) + 1.0f); h1 = 1.0f - 2.0f * __builtin_amdgcn_rcpf(__expf(2.0f * h1) + 1.0f); }
            else if (c >= 128) { h0 = sigmoidf_(h0); h1 = sigmoidf_(h1); }
        }
        *(unsigned*)(A2 + (size_t)tok * 384 + c) = cvt_pk_bf16(h0, h1);
    }
}
__device__ __forceinline__ void p4_combine(const Args& a) {
    const bf16_t* OG = (const bf16_t*)((const unsigned char*)a.out + OUT_OG); const float* LSE = (const float*)((const unsigned char*)a.out + OUT_LSE);
    bf16_t* OATT = (bf16_t*)(a.ws + WS_OATT);
    for (int i = blockIdx.x * NTHR + threadIdx.x; i < M * 64; i += gridDim.x * NTHR) {
        const int tok = i >> 6, seg = i & 63, hh = seg >> 3;
        const float l0 = LSE[(size_t)tok * 8 + hh], l1 = LSE[(size_t)M * 8 + (size_t)tok * 8 + hh], l2 = LSE[(size_t)2 * M * 8 + (size_t)tok * 8 + hh];
        const float mx = fmaxf(l0, fmaxf(l1, l2));
        float w0 = __expf(l0 - mx), w1 = __expf(l1 - mx), w2 = __expf(l2 - mx);
        const float inv = __builtin_amdgcn_rcpf(w0 + w1 + w2); w0 *= inv; w1 *= inv; w2 *= inv;
        const u32x4 o0 = *(const u32x4*)(OG + (size_t)tok * 512 + seg * 8), o1 = *(const u32x4*)(OG + (size_t)M * 512 + (size_t)tok * 512 + seg * 8),
                    o2 = *(const u32x4*)(OG + (size_t)2 * M * 512 + (size_t)tok * 512 + seg * 8);
        u32x4 w;
        w.x = cvt_pk_bf16(w0 * lo_bf(o0.x) + w1 * lo_bf(o1.x) + w2 * lo_bf(o2.x), w0 * hi_bf(o0.x) + w1 * hi_bf(o1.x) + w2 * hi_bf(o2.x));
        w.y = cvt_pk_bf16(w0 * lo_bf(o0.y) + w1 * lo_bf(o1.y) + w2 * lo_bf(o2.y), w0 * hi_bf(o0.y) + w1 * hi_bf(o1.y) + w2 * hi_bf(o2.y));
        w.z = cvt_pk_bf16(w0 * lo_bf(o0.z) + w1 * lo_bf(o1.z) + w2 * lo_bf(o2.z), w0 * hi_bf(o0.z) + w1 * hi_bf(o1.z) + w2 * hi_bf(o2.z));
        w.w = cvt_pk_bf16(w0 * lo_bf(o0.w) + w1 * lo_bf(o1.w) + w2 * lo_bf(o2.w), w0 * hi_bf(o0.w) + w1 * hi_bf(o1.w) + w2 * hi_bf(o2.w));
        *(u32x4*)(OATT + (size_t)tok * 512 + seg * 8) = w;
    }
}

constexpr int QP = 72, VP = 392;
constexpr int ATT_Q = 0, ATT_K = 256 * QP * 2, ATT_V = ATT_K + 384 * QP * 2;
constexpr int ATT_ITEMS = 3072;
struct AttItem { int g, b, hh, r, n, dsh; };
__device__ __forceinline__ AttItem att_decode(int item) {
    AttItem it; it.g = item / 1024; it.b = (item >> 8) & 3; it.hh = (item >> 5) & 7; const int rb = item & 31;
    it.dsh = 2 * it.g; const int nbk = 32 >> it.dsh; it.r = rb / nbk; it.n = 2 * (rb % nbk); return it;
}
__device__ __forceinline__ void att_load(const bf16_t* QKVA, const AttItem& it, int tid, u32x4 (&q)[4], u32x4 (&k)[6], u32x4 (&v)[6]) {
    const size_t SEC = (size_t)3 * 8 * 4 * T * 64;
    const int L = T >> it.dsh;
    const bf16_t* base = QKVA + ((((size_t)(it.g * 8 + it.hh) * 4 + it.b) * T + (size_t)it.r * L) << 6);
#pragma unroll
    for (int i = 0; i < 4; ++i) { const int p = tid + i * NTHR, row = p >> 3, seg = p & 7;
        q[i] = *(const u32x4*)(base + ((size_t)(128 * it.n + row) << 6) + seg * 8); }
#pragma unroll
    for (int i = 0; i < 6; ++i) { const int p = tid + i * NTHR, row = p >> 3, seg = p & 7; const int uu = 128 * (it.n - 1) + row;
        k[i] = (u32x4){0u, 0u, 0u, 0u};
        if (uu >= 0) k[i] = *(const u32x4*)(base + SEC + ((size_t)uu << 6) + seg * 8); }
#pragma unroll
    for (int i = 0; i < 3; ++i) { const int idx = tid + i * NTHR, kp = idx % 192, seg = idx / 192; const int uu = 128 * (it.n - 1) + 2 * kp;
        v[2 * i] = (u32x4){0u, 0u, 0u, 0u}; v[2 * i + 1] = (u32x4){0u, 0u, 0u, 0u};
        if (uu >= 0) { const bf16_t* vp = base + 2 * SEC + ((size_t)uu << 6) + seg * 8;
                       v[2 * i] = *(const u32x4*)vp; v[2 * i + 1] = *(const u32x4*)(vp + 64); } }
}
__device__ __forceinline__ void att_store(LAS bf16_t* Qs, LAS bf16_t* Ks, LAS bf16_t* Vt, int tid, const u32x4 (&q)[4], const u32x4 (&k)[6], const u32x4 (&v)[6]) {
#pragma unroll
    for (int i = 0; i < 4; ++i) { const int p = tid + i * NTHR, row = p >> 3, seg = p & 7; *(LAS u32x4*)(Qs + row * QP + seg * 8) = q[i]; }
#pragma unroll
    for (int i = 0; i < 6; ++i) { const int p = tid + i * NTHR, row = p >> 3, seg = p & 7; *(LAS u32x4*)(Ks + row * QP + seg * 8) = k[i]; }
#pragma unroll
    for (int i = 0; i < 3; ++i) { const int idx = tid + i * NTHR, kp = idx % 192, seg = idx / 192;
        const int k0 = 2 * kp, vpos = (k0 & ~31) + 8 * ((k0 >> 2) & 3) + 4 * ((k0 >> 4) & 1) + (k0 & 3);
        LAS unsigned* vd = (LAS unsigned*)(Vt + (seg * 8) * VP + vpos);
        const u32x4 a = v[2 * i], b2 = v[2 * i + 1];
        vd[0 * (VP / 2)] = (a.x & 0xffffu) | (b2.x << 16); vd[1 * (VP / 2)] = (a.x >> 16) | (b2.x & 0xffff0000u);
        vd[2 * (VP / 2)] = (a.y & 0xffffu) | (b2.y << 16); vd[3 * (VP / 2)] = (a.y >> 16) | (b2.y & 0xffff0000u);
        vd[4 * (VP / 2)] = (a.z & 0xffffu) | (b2.z << 16); vd[5 * (VP / 2)] = (a.z >> 16) | (b2.z & 0xffff0000u);
        vd[6 * (VP / 2)] = (a.w & 0xffffu) | (b2.w << 16); vd[7 * (VP / 2)] = (a.w >> 16) | (b2.w & 0xffff0000u); }
}
__device__ __forceinline__ void p3_attention(const Args& a, LAS unsigned char* lds) {
    const int tid = threadIdx.x, lane = tid & 63, w = tid >> 6, l15 = lane & 15, q4 = lane >> 4;
    const bf16_t* QKVA = (const bf16_t*)(a.ws + WS_QKVA);
    bf16_t* OG = (bf16_t*)((unsigned char*)a.out + OUT_OG); float* LSE = (float*)((unsigned char*)a.out + OUT_LSE);
    LAS bf16_t* Qs = (LAS bf16_t*)(lds + ATT_Q); LAS bf16_t* Ks = (LAS bf16_t*)(lds + ATT_K); LAS bf16_t* Vt = (LAS bf16_t*)(lds + ATT_V);
    const int G = gridDim.x, bx = blockIdx.x;
    const int vcu = (G % 8 == 0) ? (bx % 8) * (G / 8) + bx / 8 : bx;
    u32x4 rq[4], rk[6], rv[6];
    int item = vcu;
    if (item < ATT_ITEMS) { const AttItem it = att_decode(item); att_load(QKVA, it, tid, rq, rk, rv); }
    __syncthreads();
    if (item < ATT_ITEMS) att_store(Qs, Ks, Vt, tid, rq, rk, rv);
    __syncthreads();
    for (; item < ATT_ITEMS; item += G) {
        const AttItem it = att_decode(item);
        const int g = it.g, b = it.b, hh = it.hh, r = it.r, dsh = it.dsh, d = 1 << dsh;
        const int nxt = item + G;
        if (nxt < ATT_ITEMS) { const AttItem itn = att_decode(nxt); att_load(QKVA, itn, tid, rq, rk, rv); }
        const int cb = 32 * (w >> 1);
        const int iq = 16 * w + l15;
#pragma unroll
        for (int sb = 0; sb < 2; ++sb) {
        const int n = it.n + sb, qo = 128 * sb, cbs = 128 * sb + cb;
        bf16x8 qf[2];
#pragma unroll
        for (int ks = 0; ks < 2; ++ks) qf[ks] = *(const LAS bf16x8*)(Qs + (qo + iq) * QP + ks * 32 + q4 * 8);
        f32x4 s[10];
#pragma unroll
        for (int i = 0; i < 10; ++i) {
            s[i] = (f32x4){0.f, 0.f, 0.f, 0.f};
#pragma unroll
            for (int ks = 0; ks < 2; ++ks) { const bf16x8 kf = *(const LAS bf16x8*)(Ks + (cbs + 16 * i + l15) * QP + ks * 32 + q4 * 8);
                s[i] = __builtin_amdgcn_mfma_f32_16x16x32_bf16(kf, qf[ks], s[i], 0, 0, 0); }
        }
        const int sidx = 8 * g + hh;
        const float nslope = -1.4426950408889634f * exp2f(sidx < 16 ? -0.25f * (float)(sidx + 1) : -4.0f - 0.5f * (float)(sidx - 15)) * (float)d;
        const float basef = (float)(iq - cb - 4 * q4 + 128);
        const float dhi = (n > 0) ? 128.0f : fminf(128.0f, (float)iq);
        float mx = -1e30f;
#pragma unroll
        for (int i = 0; i < 10; ++i)
#pragma unroll
            for (int j = 0; j < 4; ++j) { const float dl = basef - (float)(16 * i + j);
                const bool valid = __builtin_fmaxf(__builtin_fminf(dl, dhi), 0.0f) == dl;
                const float v = valid ? __builtin_fmaf(nslope, dl, s[i][j]) : -1e30f; s[i][j] = v; mx = fmaxf(mx, v); }
        { const int xi = __float_as_int(mx); const auto r16 = __builtin_amdgcn_permlane16_swap(xi, xi, false, false); mx = fmaxf(__int_as_float(r16[0]), __int_as_float(r16[1]));
          const int yi = __float_as_int(mx); const auto r32 = __builtin_amdgcn_permlane32_swap(yi, yi, false, false); mx = fmaxf(__int_as_float(r32[0]), __int_as_float(r32[1])); }
        float den = 0.f;
#pragma unroll
        for (int i = 0; i < 10; ++i)
#pragma unroll
            for (int j = 0; j < 4; ++j) { const float p = __builtin_amdgcn_exp2f(s[i][j] - mx); s[i][j] = p; den += p; }
        { const int xi = __float_as_int(den); const auto r16 = __builtin_amdgcn_permlane16_swap(xi, xi, false, false); den = __int_as_float(r16[0]) + __int_as_float(r16[1]);
          const int yi = __float_as_int(den); const auto r32 = __builtin_amdgcn_permlane32_swap(yi, yi, false, false); den = __int_as_float(r32[0]) + __int_as_float(r32[1]); }
        f32x4 o[4];
#pragma unroll
        for (int dt = 0; dt < 4; ++dt) o[dt] = (f32x4){0.f, 0.f, 0.f, 0.f};
#pragma unroll
        for (int c = 0; c < 5; ++c) {
            u32x4 pw; pw.x = cvt_pk_bf16(s[2 * c][0], s[2 * c][1]); pw.y = cvt_pk_bf16(s[2 * c][2], s[2 * c][3]); pw.z = cvt_pk_bf16(s[2 * c + 1][0], s[2 * c + 1][1]); pw.w = cvt_pk_bf16(s[2 * c + 1][2], s[2 * c + 1][3]);
            const bf16x8 pf = __builtin_bit_cast(bf16x8, pw);
#pragma unroll
            for (int dt = 0; dt < 4; ++dt) {
                const bf16x8 vf = *(const LAS bf16x8*)(Vt + (dt * 16 + l15) * VP + cbs + 32 * c + 8 * q4);
                o[dt] = __builtin_amdgcn_mfma_f32_16x16x32_bf16(vf, pf, o[dt], 0, 0, 0);
            }
        }
        const float inv = __builtin_amdgcn_rcpf(den);
        const size_t tok = (size_t)b * T + (((128 * n + iq) << dsh) + r);
        bf16_t* op = OG + (size_t)g * M * 512 + tok * 512 + hh * 64 + q4 * 4;
#pragma unroll
        for (int dt = 0; dt < 4; ++dt) { u32x2 ww; ww.x = cvt_pk_bf16(o[dt][0] * inv, o[dt][1] * inv); ww.y = cvt_pk_bf16(o[dt][2] * inv, o[dt][3] * inv); *(u32x2*)(op + dt * 16) = ww; }
        if (q4 == 0) LSE[(size_t)g * M * 8 + tok * 8 + hh] = (mx + __builtin_amdgcn_logf(den)) * 0.6931471805599453f;
        }
        __syncthreads();
        if (nxt < ATT_ITEMS) att_store(Qs, Ks, Vt, tid, rq, rk, rv);
        __syncthreads();
    }
}

constexpr int TC = 32, SPITCH = 392;
typedef float f32x2 __attribute__((ext_vector_type(2)));
template <int CTRL> __device__ __forceinline__ float dpp_f(float x) { return __int_as_float(__builtin_amdgcn_update_dpp(0, __float_as_int(x), CTRL, 0xf, 0xf, false)); }
struct ScanRegs { u32x2 pr, pk, pv, qr, qk, qv, wl, as; };
__device__ __forceinline__ void scan_issue(ScanRegs& R, const bf16_t* PRKV, const unsigned short* WLOG, const bf16_t* ASIG, size_t tok, int ch, int want_prev) {
    const bf16_t* pp = PRKV + tok * 3072 + ch;
    R.pr = *(const u32x2*)pp; R.pk = *(const u32x2*)(pp + 1024); R.pv = *(const u32x2*)(pp + 2048);
    R.qr = (u32x2){0u, 0u}; R.qk = (u32x2){0u, 0u}; R.qv = (u32x2){0u, 0u};
    if (want_prev == 1) { R.qr = *(const u32x2*)(pp - 3072); R.qk = *(const u32x2*)(pp - 3072 + 1024); R.qv = *(const u32x2*)(pp - 3072 + 2048); }
    R.wl = *(const u32x2*)(WLOG + tok * 1024 + ch); R.as = *(const u32x2*)(ASIG + tok * 1024 + ch);
}
__device__ __forceinline__ void unpack4(const u32x2 u, float (&f)[4]) { f[0] = lo_bf(u.x); f[1] = hi_bf(u.x); f[2] = lo_bf(u.y); f[3] = hi_bf(u.y); }
__device__ __forceinline__ float scan_prepare(const ScanRegs& R, const u32x2 qr_, const u32x2 qk_, const u32x2 qv_, LAS float* slot, int cq, const f32x4 mur, const f32x4 muk, const f32x4 muv, const f32x4 kkc, const f32x4 kac, const f32x4 rkc) {
    float pr[4], pk[4], pv[4], qr[4], qk[4], qv[4], av[4], om[4];
    unpack4(R.pr, pr); unpack4(R.pk, pk); unpack4(R.pv, pv); unpack4(qr_, qr); unpack4(qk_, qk); unpack4(qv_, qv); unpack4(R.as, av);
    om[0] = f16_to_f((unsigned short)(R.wl.x & 0xffffu)); om[1] = f16_to_f((unsigned short)(R.wl.x >> 16)); om[2] = f16_to_f((unsigned short)(R.wl.y & 0xffffu)); om[3] = f16_to_f((unsigned short)(R.wl.y >> 16));
    float rr[4], vv[4], kn[4], k2[4], dec[4], bu[4];
    float ssq = 0.f, bon = 0.f, c1 = 0.f, c2 = 0.f;
#pragma unroll
    for (int j = 0; j < 4; ++j) {
        rr[j] = pr[j] + (qr[j] - pr[j]) * mur[j]; const float kk0 = pk[j] + (qk[j] - pk[j]) * muk[j]; vv[j] = pv[j] + (qv[j] - pv[j]) * muv[j];
        dec[j] = 1.0f - om[j];
        kn[j] = kk0 * kkc[j]; ssq += kn[j] * kn[j];
        k2[j] = kk0 * (1.0f + (av[j] - 1.0f) * kac[j]);
        const float t = rr[j] * k2[j]; bon += t * rkc[j]; c2 += t;
        bu[j] = kn[j] * av[j]; c1 += bu[j] * rr[j];
    }
    ssq += dpp_f<0x121>(ssq); bon += dpp_f<0x121>(bon); c1 += dpp_f<0x121>(c1); c2 += dpp_f<0x121>(c2);
    ssq += dpp_f<0x122>(ssq); bon += dpp_f<0x122>(bon); c1 += dpp_f<0x122>(c1); c2 += dpp_f<0x122>(c2);
    ssq += dpp_f<0x124>(ssq); bon += dpp_f<0x124>(bon); c1 += dpp_f<0x124>(c1); c2 += dpp_f<0x124>(c2);
    ssq += dpp_f<0x128>(ssq); bon += dpp_f<0x128>(bon); c1 += dpp_f<0x128>(c1); c2 += dpp_f<0x128>(c2);
    const float inv = __builtin_amdgcn_rsqf(fmaxf(ssq, 1e-24f));
    f32x4 o_al, o_be, o_wr;
#pragma unroll
    for (int j = 0; j < 4; ++j) { o_al[j] = -(kn[j] * inv); o_be[j] = bu[j] * inv; o_wr[j] = dec[j] * rr[j]; }
    LAS f32x4* s4 = (LAS f32x4*)slot;
    s4[cq] = (f32x4){dec[0], dec[1], dec[2], dec[3]}; s4[16 + cq] = (f32x4){k2[0], k2[1], k2[2], k2[3]}; s4[32 + cq] = o_al; s4[48 + cq] = o_be; s4[64 + cq] = o_wr;
    s4[80 + cq] = (f32x4){vv[0], vv[1], vv[2], vv[3]};
    if (cq == 0) *(LAS f32x2*)(slot + 384) = (f32x2){c1 * inv, c2};
    return bon;
}
__device__ __forceinline__ float ysum4(const LAS float* p) { const f32x4 a = *(const LAS f32x4*)p; return (a[0] + a[1]) + (a[2] + a[3]); }
struct ScanOps { f32x4 wv, kv, al, be, wr; f32x2 cc; float vi; };
__device__ __forceinline__ void scan_ld(ScanOps& o, const LAS float* sl, int jq4, int myrow) {
    o.al = *(const LAS f32x4*)(sl + 128 + jq4); o.wr = *(const LAS f32x4*)(sl + 256 + jq4); o.vi = sl[320 + myrow]; o.kv = *(const LAS f32x4*)(sl + 64 + jq4);
    o.be = *(const LAS f32x4*)(sl + 192 + jq4); o.wv = *(const LAS f32x4*)(sl + jq4); o.cc = *(const LAS f32x2*)(sl + 384);
}
__device__ __forceinline__ void p8_scan(const Args& a, LAS unsigned char* lds) {
    const int tid = threadIdx.x, lane = tid & 63, w = __builtin_amdgcn_readfirstlane(tid >> 6);
    const bf16_t* PRKV = (const bf16_t*)(a.ws + WS_PRKV); const unsigned short* WLOG = (const unsigned short*)(a.ws + WS_WLOG);
    const bf16_t* ASIG = (const bf16_t*)((const unsigned char*)a.out + OUT_ASIG);
    bf16_t* Y = (bf16_t*)(a.ws + WS_Y); float* BONUS = (float*)(a.ws + WS_BONUS);
    const float* mu_rkv = a.in[9]; const float* k_k = a.in[19]; const float* k_a = a.in[20]; const float* r_k = a.in[21];
    LAS float* buf = (LAS float*)lds;
    LAS float* ybuf = (LAS float*)(lds + 2 * TC * SPITCH * 4);
    LAS float* dump = ybuf + 2 * TC * 64;
    const int p = tid & 255, ltt = p >> 4, cq = p & 15;
    const int jq4 = 4 * (lane & 15);
    for (int item = blockIdx.x; item < 256; item += gridDim.x) {
        const int bh = item & 63, rq = item >> 6, b = bh >> 4, h = bh & 15;
        const int ch = h * 64 + 4 * cq;
        const int myrow = 16 * rq + 4 * (w & 3) + (lane >> 4);
        __syncthreads();
        if (w >= 4) {
            const f32x4 mur = *(const f32x4*)(mu_rkv + ch), muk = *(const f32x4*)(mu_rkv + 1024 + ch), muv = *(const f32x4*)(mu_rkv + 2048 + ch),
                        kkc = *(const f32x4*)(k_k + ch), kac = *(const f32x4*)(k_a + ch), rkc = *(const f32x4*)(r_k + ch);
            ScanRegs A0, A1, B0, B1;
            { const size_t tok = (size_t)b * T + 2 * ltt; scan_issue(A0, PRKV, WLOG, ASIG, tok, ch, ltt > 0 ? 1 : 2); scan_issue(A1, PRKV, WLOG, ASIG, tok + 1, ch, 0);
              const float b0 = scan_prepare(A0, A0.qr, A0.qk, A0.qv, buf + (2 * ltt) * SPITCH, cq, mur, muk, muv, kkc, kac, rkc);
              const float b1 = scan_prepare(A1, A0.pr, A0.pk, A0.pv, buf + (2 * ltt + 1) * SPITCH, cq, mur, muk, muv, kkc, kac, rkc);
              if (rq == 0 && cq == 0) { BONUS[tok * 16 + h] = b0; BONUS[(tok + 1) * 16 + h] = b1; }
              scan_issue(A0, PRKV, WLOG, ASIG, tok + TC, ch, 1); scan_issue(A1, PRKV, WLOG, ASIG, tok + TC + 1, ch, 0);
              scan_issue(B0, PRKV, WLOG, ASIG, tok + 2 * TC, ch, 1); scan_issue(B1, PRKV, WLOG, ASIG, tok + 2 * TC + 1, ch, 0); }
            __syncthreads();
#define PROD_STEP(c, X0, X1) do { \
                const int cur = (c) & 1; \
                const size_t tokn = (size_t)b * T + ((c) + 1) * TC + 2 * ltt; \
                if ((c) > 0) { const LAS float* yb = ybuf + (cur ^ 1) * TC * 64; bf16_t* yd = Y + ((size_t)b * T + ((c) - 1) * TC + 2 * ltt) * 1024 + h * 64 + 16 * rq + cq; \
                               yd[0] = f2bf(ysum4(yb + (2 * ltt) * 64 + cq * 4)); yd[1024] = f2bf(ysum4(yb + (2 * ltt + 1) * 64 + cq * 4)); } \
                if ((c) + 1 < T / TC) { \
                    LAS float* nb = buf + (cur ^ 1) * TC * SPITCH; \
                    const float b0 = scan_prepare(X0, X0.qr, X0.qk, X0.qv, nb + (2 * ltt) * SPITCH, cq, mur, muk, muv, kkc, kac, rkc); \
                    const float b1 = scan_prepare(X1, X0.pr, X0.pk, X0.pv, nb + (2 * ltt + 1) * SPITCH, cq, mur, muk, muv, kkc, kac, rkc); \
                    if (rq == 0 && cq == 0) { BONUS[tokn * 16 + h] = b0; BONUS[(tokn + 1) * 16 + h] = b1; } \
                    if ((c) + 3 < T / TC) { scan_issue(X0, PRKV, WLOG, ASIG, tokn + 2 * TC, ch, 1); scan_issue(X1, PRKV, WLOG, ASIG, tokn + 2 * TC + 1, ch, 0); } \
                } \
                __syncthreads(); } while (0)
            for (int c = 0; c < T / TC; c += 2) { PROD_STEP(c, A0, A1); PROD_STEP(c + 1, B0, B1); }
#undef PROD_STEP
            { const LAS float* yb = ybuf + 1 * TC * 64; bf16_t* yd = Y + ((size_t)b * T + (T / TC - 1) * TC + 2 * ltt) * 1024 + h * 64 + 16 * rq + cq;
              yd[0] = f2bf(ysum4(yb + (2 * ltt) * 64 + cq * 4)); yd[1024] = f2bf(ysum4(yb + (2 * ltt + 1) * 64 + cq * 4)); }
        } else {
            f32x2 S01 = (f32x2){0.f, 0.f}, S23 = (f32x2){0.f, 0.f};
            const bool holds_y = (lane & 3) == 0;
            const float m0 = (lane & 15) == 0 ? 1.0f : 0.0f;
            __syncthreads();
            for (int c = 0; c < T / TC; ++c) {
                const int cur = c & 1;
                const LAS float* bt = buf + cur * TC * SPITCH;
                LAS float* yd = holds_y ? (ybuf + cur * TC * 64 + 4 * (4 * w + (lane >> 4)) + ((lane & 15) >> 2)) : (dump + lane);
                ScanOps o; scan_ld(o, bt, jq4, myrow);
#pragma unroll 16
                for (int tt = 0; tt < TC; ++tt) {
                    ScanOps n; scan_ld(n, bt + (tt + 1 < TC ? tt + 1 : tt) * SPITCH, jq4, myrow);
                    __builtin_amdgcn_sched_barrier(0);
                    f32x2 ta = S01 * o.al.lo, ty = S01 * o.wr.lo; ta = S23 * o.al.hi + ta; ty = S23 * o.wr.hi + ty;
                    float pa = ta.x + ta.y, py = ty.x + ty.y;
                    f32x2 kv01 = o.kv.lo * o.vi, kv23 = o.kv.hi * o.vi;
                    float vc = o.vi * o.cc.y;
                    asm volatile("" : "+v"(kv01), "+v"(kv23), "+v"(vc));
                    pa += dpp_f<0x121>(pa); py += dpp_f<0x121>(py); pa += dpp_f<0x122>(pa); py += dpp_f<0x122>(py);
                    pa += dpp_f<0x124>(pa); pa += dpp_f<0x128>(pa);
                    S01 = S01 * o.wv.lo + (o.be.lo * pa + kv01);
                    S23 = S23 * o.wv.hi + (o.be.hi * pa + kv23);
                    yd[tt * 64] = (pa * o.cc.x + vc) * m0 + py;
                    __builtin_amdgcn_sched_barrier(0);
                    o = n;
                }
                __syncthreads();
            }
        }
    }
}
struct P8bRow { u32x4 y0, y1, v0, v1, g0, g1; float bon; };
__device__ __forceinline__ void p8b_load(P8bRow& r, const bf16_t* Y, const bf16_t* PRKV, const bf16_t* GG, const float* BONUS, int row, int c0, int lane) {
    r.y0 = *(const u32x4*)(Y + (size_t)row * 1024 + c0); r.y1 = *(const u32x4*)(Y + (size_t)row * 1024 + c0 + 8);
    r.v0 = *(const u32x4*)(PRKV + (size_t)row * 3072 + 2048 + c0); r.v1 = *(const u32x4*)(PRKV + (size_t)row * 3072 + 2048 + c0 + 8);
    r.g0 = *(const u32x4*)(GG + (size_t)row * 1024 + c0); r.g1 = *(const u32x4*)(GG + (size_t)row * 1024 + c0 + 8);
    r.bon = BONUS[(size_t)row * 16 + (lane >> 2)];
}
__device__ __forceinline__ void unpack8(const u32x4 u, float (&f)[8]) { f[0] = lo_bf(u.x); f[1] = hi_bf(u.x); f[2] = lo_bf(u.y); f[3] = hi_bf(u.y); f[4] = lo_bf(u.z); f[5] = hi_bf(u.z); f[6] = lo_bf(u.w); f[7] = hi_bf(u.w); }
__device__ __forceinline__ void p8b_post(const Args& a) {
    const int lane = threadIdx.x & 63, wave = threadIdx.x >> 6;
    const bf16_t* PRKV = (const bf16_t*)(a.ws + WS_PRKV); bf16_t* Y = (bf16_t*)(a.ws + WS_Y); const float* BONUS = (const float*)(a.ws + WS_BONUS);
    const bf16_t* GG = (const bf16_t*)((const unsigned char*)a.out + OUT_GG);
    const float* muv = a.in[9] + 2048; const float* lnw = a.in[22]; const float* lnb = a.in[23];
    const int c0 = lane * 16;
    f32x4 mu[4], lw[4], lb[4];
#pragma unroll
    for (int i = 0; i < 4; ++i) { mu[i] = *(const f32x4*)(muv + c0 + 4 * i); lw[i] = *(const f32x4*)(lnw + c0 + 4 * i); lb[i] = *(const f32x4*)(lnb + c0 + 4 * i); }
    for (int base = (blockIdx.x * 8 + wave) * RPW; base < M; base += gridDim.x * 8 * RPW) {
        u32x4 p0 = (u32x4){0u, 0u, 0u, 0u}, p1 = (u32x4){0u, 0u, 0u, 0u};
        if ((base & (T - 1)) != 0) { p0 = *(const u32x4*)(PRKV + (size_t)(base - 1) * 3072 + 2048 + c0); p1 = *(const u32x4*)(PRKV + (size_t)(base - 1) * 3072 + 2048 + c0 + 8); }
        P8bRow r; p8b_load(r, Y, PRKV, GG, BONUS, base, c0, lane);
#pragma unroll 2
        for (int k = 0; k < RPW; ++k) {
            const int row = base + k, rn = (k + 1 < RPW) ? row + 1 : row;
            P8bRow n; p8b_load(n, Y, PRKV, GG, BONUS, rn, c0, lane);
            float y[16];
            { float t0[8], t1[8]; unpack8(r.y0, t0); unpack8(r.y1, t1);
#pragma unroll
              for (int j = 0; j < 8; ++j) { y[j] = t0[j]; y[8 + j] = t1[j]; } }
            float s = 0.f;
#pragma unroll
            for (int j = 0; j < 16; ++j) s += y[j];
            s += __shfl_xor(s, 1); s += __shfl_xor(s, 2);
            const float mean = s * (1.0f / 64.0f);
            float q = 0.f;
#pragma unroll
            for (int j = 0; j < 16; ++j) { y[j] -= mean; q += y[j] * y[j]; }
            q += __shfl_xor(q, 1); q += __shfl_xor(q, 2);
            const float rstd = rsqrtf(q * (1.0f / 64.0f) + 64e-5f);
#pragma unroll
            for (int hf = 0; hf < 2; ++hf) {
                float cur[8], prv[8], gv[8];
                unpack8(hf ? r.v1 : r.v0, cur); unpack8(hf ? p1 : p0, prv); unpack8(hf ? r.g1 : r.g0, gv);
                float o[8];
#pragma unroll
                for (int j = 0; j < 8; ++j) { const int jj = hf * 8 + j; const float v = cur[j] + (prv[j] - cur[j]) * mu[jj >> 2][jj & 3];
                                              o[j] = ((y[jj] * rstd) * lw[jj >> 2][jj & 3] + lb[jj >> 2][jj & 3] + r.bon * v) * gv[j]; }
                u32x4 wv; wv.x = cvt_pk_bf16(o[0], o[1]); wv.y = cvt_pk_bf16(o[2], o[3]); wv.z = cvt_pk_bf16(o[4], o[5]); wv.w = cvt_pk_bf16(o[6], o[7]);
                *(u32x4*)(Y + (size_t)row * 1024 + c0 + hf * 8) = wv;
            }
            p0 = r.v0; p1 = r.v1; r = n;
        }
    }
}

__global__ void __launch_bounds__(NTHR, 2) mega(Args a) {
    extern __shared__ __attribute__((aligned(16))) unsigned char lds_raw[];
    LAS unsigned char* lds = (LAS unsigned char*)lds_raw;
    cg::grid_group grid = cg::this_grid();
    unsigned char* ws = a.ws;
    volatile LAS unsigned* bst = (volatile LAS unsigned*)(lds + LDS_BYTES - 16);
    if (threadIdx.x == 0) { bst[0] = 0u; bst[1] = 0u; }
    __syncthreads();
    XcdBarrier bar = xcd_barrier_post((unsigned*)(ws + WS_BAR), bst);
    const int lo = a.ph_lo, hi = a.ph_hi;
#ifndef PHMASK
#define PHMASK 0x3ffff
#endif
#define IN(k) (((PHMASK >> (k)) & 1) && lo <= (k) && (k) < hi)
#define SYNC(k) do { if ((k) + 1 < hi) { if (lo < 0) grid.sync(); else xcd_barrier(bar); } } while (0)
    if (IN(0)) { p0_prologue(a, lds); SYNC(0); }
    if (IN(1)) { p1_prenorm(a); SYNC(1); }
    if (IN(2)) { Epi<EP_QKV> E{(bf16_t*)(ws + WS_QKVA), 4608, nullptr, nullptr, nullptr, nullptr, nullptr, nullptr};
                 run_gemm<EP_QKV>(lds, (const bf16_t*)(ws + WS_HB), (const bf16_t*)(ws + WS_WA), 4608, 1024, E); SYNC(2); }
    if (IN(3)) { p3_attention(a, lds); SYNC(3); }
    if (IN(4)) { p4_combine(a); }
    if (IN(5)) { Epi<EP_SPLIT> E{(bf16_t*)(ws + WS_PRKV), 3072, (bf16_t*)(ws + WS_P), nullptr, nullptr, nullptr, nullptr, nullptr};
                 run_gemm<EP_SPLIT>(lds, (const bf16_t*)(ws + WS_HB), (const bf16_t*)(ws + WS_WB), 3840, 1024, E); SYNC(5); }
    if (IN(6)) { p6_loramid(a); SYNC(6); }
    if (IN(7)) { Epi<EP_L2> E{(bf16_t*)(ws + WS_WLOG), 1024, (bf16_t*)((unsigned char*)a.out + OUT_ASIG), (bf16_t*)((unsigned char*)a.out + OUT_GG), nullptr, nullptr, a.in[11], a.in[14]};
                 run_gemm<EP_L2>(lds, (const bf16_t*)(ws + WS_A2), (const bf16_t*)(ws + WS_W2), 3072, 384, E); SYNC(7); }
    if (IN(8)) { p8_scan(a, lds); SYNC(8); }
    if (IN(9)) { p8b_post(a); }
    if (IN(10)) { Epi<EP_SIG> E{(bf16_t*)((unsigned char*)a.out + OUT_ASIG), 1024, (bf16_t*)(ws + WS_WLOG), nullptr, nullptr, nullptr, nullptr, nullptr};
                  run_gemm<EP_SIG>(lds, (const bf16_t*)(ws + WS_HB), (const bf16_t*)(ws + WS_WC), 2048, 1024, E); SYNC(10); }
    if (IN(11)) { Epi<EP_MULG> E{(bf16_t*)(ws + WS_T1), 1024, nullptr, nullptr, (const bf16_t*)((const unsigned char*)a.out + OUT_ASIG), nullptr, nullptr, nullptr};
                  run_gemm<EP_MULG>(lds, (const bf16_t*)(ws + WS_Y), (const bf16_t*)(ws + WS_WOR), 1024, 1024, E); }
    if (IN(12)) { Epi<EP_MIX> E{(bf16_t*)(ws + WS_MIXIN), 1024, nullptr, nullptr, (const bf16_t*)(ws + WS_WLOG), (const bf16_t*)(ws + WS_T1), nullptr, nullptr};
                  run_gemm<EP_MIX>(lds, (const bf16_t*)(ws + WS_OATT), (const bf16_t*)(ws + WS_WOA), 1024, 512, E); SYNC(12); }
    if (IN(13)) { Epi<EP_PLAIN> E{(bf16_t*)(ws + WS_MIXED), 1024, nullptr, nullptr, nullptr, nullptr, nullptr, nullptr};
                  run_gemm<EP_PLAIN>(lds, (const bf16_t*)(ws + WS_MIXIN), (const bf16_t*)(ws + WS_WOUT), 1024, 1024, E); SYNC(13); }
    if (IN(14)) { p13_mid(a); SYNC(14); }
    if (IN(15)) { Epi<EP_SWIGLU> E{(bf16_t*)(ws + WS_U), 2816, nullptr, nullptr, nullptr, nullptr, nullptr, nullptr};
                  run_gemm<EP_SWIGLU>(lds, (const bf16_t*)(ws + WS_HB), (const bf16_t*)(ws + WS_WFI), 5632, 1024, E); SYNC(15); }
    if (IN(16)) { Epi<EP_PLAIN> E{(bf16_t*)(ws + WS_Y2), 1024, nullptr, nullptr, nullptr, nullptr, nullptr, nullptr};
                  run_gemm<EP_PLAIN>(lds, (const bf16_t*)(ws + WS_U), (const bf16_t*)(ws + WS_WFO), 1024, 2816, E); SYNC(16); }
    if (IN(17)) { p16_final(a); }
#undef IN
#undef SYNC
}

#ifndef MK_MULTI
#define MK_MULTI 0
#endif
extern "C" void kernel_launch(void* const* d_in, const int* in_sizes, int n_in, void* d_out, int out_size, void* d_ws, size_t ws_size, hipStream_t stream) {
    static int grid = 0;
    if (grid == 0) {
        if (n_in != 29 || out_size != M * D || ws_size < WS_END) { fprintf(stderr, "kernel_launch: unexpected problem shape (n_in %d out %d ws %zu)\n", n_in, out_size, ws_size); grid = -1; return; }
        int dev = 0, cus = 0, per_cu = 0;
        hipGetDevice(&dev);
        hipDeviceGetAttribute(&cus, hipDeviceAttributeMultiprocessorCount, dev);
        hipFuncSetAttribute((const void*)mega, hipFuncAttributeMaxDynamicSharedMemorySize, LDS_BYTES);
        hipOccupancyMaxActiveBlocksPerMultiprocessor(&per_cu, (const void*)mega, NTHR, LDS_BYTES);
        if (per_cu < 1) per_cu = 1;
        grid = cus * per_cu;
        (void)hipGetLastError();
    }
    if (grid < 0) return;
    Args a{};
    for (int i = 0; i < 29; ++i) a.in[i] = (const float*)d_in[i];
    a.out = (float*)d_out; a.ws = (unsigned char*)d_ws;
#if MK_MULTI
    for (int ph = 0; ph < NPHASE; ++ph) { a.ph_lo = ph; a.ph_hi = ph + 1; hipLaunchKernelGGL(mega, dim3(grid), dim3(NTHR), LDS_BYTES, stream, a); }
#else
    a.ph_lo = 0; a.ph_hi = NPHASE;
    if (hipMemsetAsync((unsigned char*)d_ws + WS_BAR, 0, XCD_BAR_WORDS * 4, stream) != hipSuccess) { fprintf(stderr, "kernel_launch: memset of the barrier words failed\n"); return; }
    void* args[] = {&a};
    hipError_t e = hipLaunchCooperativeKernel((const void*)mega, dim3(grid), dim3(NTHR), args, LDS_BYTES, stream);
    if (e != hipSuccess) fprintf(stderr, "cooperative launch failed: %s (grid %d)\n", hipGetErrorString(e), grid);
#endif
}
```
